# Optimizing an MI355X kernel written in HIP

```python
import jax, jax.numpy as jnp
from jax import lax
import numpy as np

D_MODEL = 1024
BATCH = 1
SEQ = 16384
DEPTH = 2

D_MIX = 2 * D_MODEL
D_MLSTM = D_MIX // 2
NH_MLSTM = 8
DH_MLSTM = D_MLSTM // NH_MLSTM
MLSTM_CHUNK = 128
D_LRU = D_MIX - D_MLSTM
NB_LRU = 8
BS_LRU = D_LRU // NB_LRU
LRU_C = 8.0
CONV_W = 4
N_EXPERTS = 32
N_GROUPS = 8
EXPERTS_PER_GROUP = N_EXPERTS // N_GROUPS
TOP_K = 2
D_FF = D_MODEL // 2
MOE_BLOCK = 128
DEEPNORM_ALPHA = (2 * DEPTH) ** 0.25
DEEPNORM_BETA = (8 * DEPTH) ** -0.25
LN_EPS = 1e-5
N_IN = 4 * D_MLSTM + 2 * NH_MLSTM + 2 * D_LRU
IN_SPLITS = (2 * D_MLSTM, 3 * D_MLSTM, 4 * D_MLSTM, 4 * D_MLSTM + NH_MLSTM,
             4 * D_MLSTM + 2 * NH_MLSTM, 4 * D_MLSTM + 2 * NH_MLSTM + D_LRU)

kernel_name = "hymba_mlstm_rglru_deepnorm_grouped_moe"


def layer_norm(x):
    xf = x.astype(jnp.float32)
    mu = jnp.mean(xf, axis=-1, keepdims=True)
    var = jnp.mean(jnp.square(xf - mu), axis=-1, keepdims=True)
    return ((xf - mu) * lax.rsqrt(var + LN_EPS)).astype(x.dtype)


def rms_norm(x):
    xf = x.astype(jnp.float32)
    return (xf * lax.rsqrt(jnp.mean(jnp.square(xf), axis=-1, keepdims=True) + LN_EPS)).astype(x.dtype)


def causal_depthwise_conv(x, w, b):
    s = x.shape[1]
    xp = jnp.pad(x, ((0, 0), (CONV_W - 1, 0), (0, 0)))
    y = b
    for k in range(CONV_W):
        y = y + xp[:, k:k + s] * w[k]
    return y


def mlstm_chunkwise(q, k, v, i_pre, log_f):
    bsz, nh, s, dh = q.shape
    nc = s // MLSTM_CHUNK

    def chunks(a):
        return jnp.moveaxis(a.reshape(bsz, nh, nc, MLSTM_CHUNK, *a.shape[3:]), 2, 0)

    causal = jnp.tril(jnp.ones((MLSTM_CHUNK, MLSTM_CHUNK), dtype=bool))

    def step(carry, xs):
        c_prev, n_prev, m_prev = carry
        qc, kc, vc, ic, lfc = xs
        b = jnp.cumsum(lfc, axis=-1)
        d_log = jnp.where(causal, b[..., :, None] - b[..., None, :] + ic[..., None, :], -jnp.inf)
        inter_log = b + m_prev[..., None]
        m_t = jnp.maximum(jnp.max(d_log, axis=-1), inter_log)
        scores = jnp.einsum('bhtd,bhsd->bhts', qc, kc) * jnp.exp(d_log - m_t[..., None])
        w_inter = jnp.exp(inter_log - m_t)
        num = (jnp.einsum('bhts,bhse->bhte', scores, vc)
               + w_inter[..., None] * jnp.einsum('bhtd,bhde->bhte', qc, c_prev))
        den = jnp.sum(scores, axis=-1) + w_inter * jnp.einsum('bhtd,bhd->bht', qc, n_prev)
        h = num / jnp.maximum(jnp.abs(den), jnp.exp(-m_t))[..., None]
        b_last = b[..., -1]
        g_log = b_last[..., None] - b + ic
        m_new = jnp.maximum(b_last + m_prev, jnp.max(g_log, axis=-1))
        decay = jnp.exp(b_last + m_prev - m_new)
        wk = jnp.exp(g_log - m_new[..., None])[..., None] * kc
        c_new = decay[..., None, None] * c_prev + jnp.einsum('bhsd,bhse->bhde', wk, vc)
        n_new = decay[..., None] * n_prev + jnp.sum(wk, axis=2)
        return (c_new, n_new, m_new), h

    init = (jnp.zeros((bsz, nh, dh, dh), jnp.float32),
            jnp.zeros((bsz, nh, dh), jnp.float32),
            jnp.zeros((bsz, nh), jnp.float32))
    _, hs = lax.scan(step, init, (chunks(q), chunks(k), chunks(v), chunks(i_pre), chunks(log_f)))
    return jnp.moveaxis(hs, 0, 2).reshape(bsz, nh, s, dh)


def linear_recurrence(a, x):
    def combine(left, right):
        a_l, x_l = left
        a_r, x_r = right
        return a_l * a_r, a_r * x_l + x_r
    _, h = lax.associative_scan(combine, (a, x), axis=1)
    return h


def hybrid_mixer(u, w_in, b_in, w_conv_m, b_conv_m, mh_norm_g, w_conv_r, b_conv_r,
                 w_a, b_a, w_x, b_x, lru_lambda, lru_norm_g, w_out):
    bsz, s, _ = u.shape
    f32 = jnp.float32
    proj = jnp.einsum('bsd,dn->bsn', u, w_in) + b_in
    qk, v, o_pre, i_pre, f_pre, x_r, g_r = jnp.split(proj, IN_SPLITS, axis=-1)

    qk = jax.nn.silu(causal_depthwise_conv(qk, w_conv_m, b_conv_m))
    q, k = jnp.split(qk, 2, axis=-1)

    def to_heads(a):
        return a.reshape(bsz, s, NH_MLSTM, DH_MLSTM).transpose(0, 2, 1, 3).astype(f32)

    h_m = mlstm_chunkwise(to_heads(q), to_heads(k) * DH_MLSTM ** -0.5, to_heads(v),
                          i_pre.astype(f32).transpose(0, 2, 1),
                          jax.nn.log_sigmoid(f_pre.astype(f32)).transpose(0, 2, 1))
    h_m = layer_norm(h_m.transpose(0, 2, 1, 3)).reshape(bsz, s, D_MLSTM)
    y_m = (jax.nn.sigmoid(o_pre.astype(f32)) * h_m).astype(u.dtype) * mh_norm_g

    xc = causal_depthwise_conv(x_r, w_conv_r, b_conv_r)
    xb = xc.reshape(bsz, s, NB_LRU, BS_LRU)
    r = jax.nn.sigmoid((jnp.einsum('bsnc,ncd->bsnd', xb, w_a).reshape(bsz, s, D_LRU) + b_a).astype(f32))
    ig = jax.nn.sigmoid((jnp.einsum('bsnc,ncd->bsnd', xb, w_x).reshape(bsz, s, D_LRU) + b_x).astype(f32))
    log_a = -LRU_C * r * jax.nn.softplus(-lru_lambda.astype(f32))
    x_in = jnp.sqrt(-jnp.expm1(2.0 * log_a)) * (ig * xc.astype(f32))
    h_r = linear_recurrence(jnp.exp(log_a), x_in)
    y_r = h_r.astype(u.dtype) * jax.nn.gelu(g_r)
    y_r = rms_norm(y_r.reshape(bsz, s, NB_LRU, BS_LRU)).reshape(bsz, s, D_LRU) * lru_norm_g

    y = jnp.concatenate([y_m, y_r], axis=-1)
    return jnp.einsum('bsm,md->bsd', y, w_out)


def grouped_moe(h, w_router, b_router, w_gate, w_up, w_down):
    t, d = h.shape
    f32 = jnp.float32
    affinity = jax.nn.sigmoid(h.astype(f32) @ w_router.astype(f32))
    sel = (affinity + b_router.astype(f32)).reshape(t, N_GROUPS, EXPERTS_PER_GROUP)
    group_score = jnp.sum(lax.top_k(sel, TOP_K)[0], axis=-1)
    grp = jnp.argmax(group_score, axis=-1).astype(jnp.int32)
    sel_in_grp = jnp.take_along_axis(sel, grp[:, None, None], axis=1)[:, 0]
    _, local = lax.top_k(sel_in_grp, TOP_K)
    experts = grp[:, None] * EXPERTS_PER_GROUP + local.astype(jnp.int32)
    gates = jnp.take_along_axis(affinity, experts, axis=1)
    gates = gates / jnp.sum(gates, axis=-1, keepdims=True)

    n_assign = t * TOP_K
    e_flat = experts.reshape(n_assign)
    tok_flat = jnp.repeat(jnp.arange(t, dtype=jnp.int32), TOP_K)
    order = jnp.argsort(e_flat)
    e_s, tok_s, g_s = e_flat[order], tok_flat[order], gates.reshape(n_assign)[order]
    counts = jnp.zeros((N_EXPERTS,), jnp.int32).at[e_flat].add(1)
    padded = (counts + MOE_BLOCK - 1) // MOE_BLOCK * MOE_BLOCK
    pend = jnp.cumsum(padded)
    pstart = pend - padded
    start = jnp.cumsum(counts) - counts
    dest = pstart[e_s] + jnp.arange(n_assign, dtype=jnp.int32) - start[e_s]
    n_blk = -(-n_assign // MOE_BLOCK) + N_EXPERTS
    rows = n_blk * MOE_BLOCK
    x_buf = jnp.zeros((rows, d), h.dtype).at[dest].set(h[tok_s])
    blk_start = jnp.arange(n_blk, dtype=jnp.int32) * MOE_BLOCK
    blk_e = jnp.minimum(jnp.searchsorted(pend, blk_start, side='right'), N_EXPERTS - 1)

    def expert_block(args):
        xb, e = args
        hid = jax.nn.silu(xb @ w_gate[e]) * (xb @ w_up[e])
        return hid @ w_down[e]

    y_buf = lax.map(expert_block, (x_buf.reshape(n_blk, MOE_BLOCK, d), blk_e))
    y = y_buf.reshape(rows, d)[dest] * g_s[:, None].astype(h.dtype)
    return jax.ops.segment_sum(y, tok_s, num_segments=t)


def setup_inputs(seed: int = 0) -> dict:
    key = jax.random.key(seed)
    ks = jax.random.split(key, 26)
    f32 = jnp.float32

    def nrm(k, shape, scale):
        return jax.random.normal(k, shape, f32) * scale

    x = nrm(ks[0], (BATCH, SEQ, D_MODEL), 1.0)
    c = nrm(ks[1], (BATCH, D_MODEL), 1.0)
    w_ada = nrm(ks[2], (DEPTH, D_MODEL, 6 * D_MODEL), 0.5 * D_MODEL ** -0.5)
    b_ada = nrm(ks[3], (DEPTH, 6 * D_MODEL), 0.02)
    w_in = nrm(ks[4], (DEPTH, D_MODEL, N_IN), D_MODEL ** -0.5)
    f_off = 4 * D_MLSTM + NH_MLSTM
    b_in = nrm(ks[5], (DEPTH, N_IN), 0.02).at[:, f_off:f_off + NH_MLSTM].add(
        jnp.linspace(3.0, 6.0, NH_MLSTM, dtype=f32))
    w_conv_m = nrm(ks[6], (DEPTH, CONV_W, 2 * D_MLSTM), CONV_W ** -0.5)
    b_conv_m = nrm(ks[7], (DEPTH, 2 * D_MLSTM), 0.02)
    mh_norm_g = 1.0 + nrm(ks[8], (DEPTH, D_MLSTM), 0.02)
    w_conv_r = nrm(ks[9], (DEPTH, CONV_W, D_LRU), CONV_W ** -0.5)
    b_conv_r = nrm(ks[10], (DEPTH, D_LRU), 0.02)
    w_a = nrm(ks[11], (DEPTH, NB_LRU, BS_LRU, BS_LRU), BS_LRU ** -0.5)
    b_a = nrm(ks[12], (DEPTH, D_LRU), 0.02)
    w_x = nrm(ks[13], (DEPTH, NB_LRU, BS_LRU, BS_LRU), BS_LRU ** -0.5)
    b_x = nrm(ks[14], (DEPTH, D_LRU), 0.02)
    a0 = jax.random.uniform(ks[15], (DEPTH, D_LRU), f32, 0.9, 0.999)
    lru_lambda = jnp.log(a0) - jnp.log1p(-a0)
    lru_norm_g = 1.0 + nrm(ks[16], (DEPTH, D_LRU), 0.02)
    w_out = nrm(ks[17], (DEPTH, D_MIX, D_MODEL), DEEPNORM_BETA * D_MIX ** -0.5)
    w_router = nrm(ks[18], (D_MODEL, N_EXPERTS), D_MODEL ** -0.5)
    b_router = nrm(ks[19], (N_EXPERTS,), 0.01)
    w_gate = nrm(ks[20], (DEPTH, N_EXPERTS, D_MODEL, D_FF), D_MODEL ** -0.5)
    w_up = nrm(ks[21], (DEPTH, N_EXPERTS, D_MODEL, D_FF), D_MODEL ** -0.5)
    w_down = nrm(ks[22], (DEPTH, N_EXPERTS, D_FF, D_MODEL), DEEPNORM_BETA * D_FF ** -0.5)
    ln_g = 1.0 + nrm(ks[23], (DEPTH, 2, D_MODEL), 0.02)
    ln_b = nrm(ks[24], (DEPTH, 2, D_MODEL), 0.02)
    return {"x": x, "c": c, "w_ada": w_ada, "b_ada": b_ada, "w_in": w_in, "b_in": b_in,
            "w_conv_m": w_conv_m, "b_conv_m": b_conv_m, "mh_norm_g": mh_norm_g,
            "w_conv_r": w_conv_r, "b_conv_r": b_conv_r, "w_a": w_a, "b_a": b_a, "w_x": w_x, "b_x": b_x,
            "lru_lambda": lru_lambda, "lru_norm_g": lru_norm_g, "w_out": w_out,
            "w_router": w_router, "b_router": b_router, "w_gate": w_gate, "w_up": w_up, "w_down": w_down,
            "ln_g": ln_g, "ln_b": ln_b}


def reference(x, c, w_ada, b_ada, w_in, b_in, w_conv_m, b_conv_m, mh_norm_g, w_conv_r, b_conv_r,
              w_a, b_a, w_x, b_x, lru_lambda, lru_norm_g, w_out, w_router, b_router,
              w_gate, w_up, w_down, ln_g, ln_b):
    bsz, s, d = x.shape
    cond = jax.nn.silu(c)
    for l in range(DEPTH):
        ada = cond @ w_ada[l] + b_ada[l]
        sh1, sc1, g1, sh2, sc2, g2 = [a[:, None, :] for a in jnp.split(ada, 6, axis=-1)]
        u = layer_norm(x) * (1.0 + sc1) + sh1
        y = hybrid_mixer(u, w_in[l], b_in[l], w_conv_m[l], b_conv_m[l], mh_norm_g[l],
                         w_conv_r[l], b_conv_r[l], w_a[l], b_a[l], w_x[l], b_x[l],
                         lru_lambda[l], lru_norm_g[l], w_out[l])
        x = layer_norm(DEEPNORM_ALPHA * x + g1 * y) * ln_g[l, 0] + ln_b[l, 0]
        u = layer_norm(x) * (1.0 + sc2) + sh2
        y = grouped_moe(u.reshape(bsz * s, d), w_router, b_router,
                        w_gate[l], w_up[l], w_down[l]).reshape(bsz, s, d)
        x = layer_norm(DEEPNORM_ALPHA * x + g2 * y) * ln_g[l, 1] + ln_b[l, 1]
    return x
```

```cpp
#include <hip/hip_runtime.h>
#include <cstdio>
#include <cstdint>

#define GAS __attribute__((address_space(1)))
#define LAS __attribute__((address_space(3)))
typedef unsigned short bf16;
typedef float f32x4 __attribute__((ext_vector_type(4)));
typedef float f32x2 __attribute__((ext_vector_type(2)));
typedef short bf16x8 __attribute__((ext_vector_type(8)));
typedef unsigned u32x4 __attribute__((ext_vector_type(4)));
typedef unsigned u32x2 __attribute__((ext_vector_type(2)));

constexpr int S = 16384, D = 1024, DEPTH = 2, NH = 8, DH = 128, CH = 128, NC = S / CH, NE = 32, DFF = 512;
constexpr int NIN = 6160, NPROJ = 6144;
constexpr float LN_EPS = 1e-5f;
constexpr float ALPHA = 1.41421356237f;
constexpr int NPH = 2 + 9 * DEPTH;

constexpr size_t MiB = 1u << 20;
constexpr size_t WS_CTL = 0, CTL_BYTES = 131072;
constexpr size_t WS_ADA = 1 * MiB;
constexpr size_t WS_IFG = 2 * MiB;
constexpr size_t WS_BCUM = 3 * MiB;
constexpr size_t WS_CHS = 3 * MiB + 512 * 1024;
constexpr size_t WS_MST = WS_CHS + 16384;
constexpr size_t WS_NLOC = 4 * MiB;
constexpr size_t WS_NST = 4 * MiB + 512 * 1024;
constexpr size_t WS_AC = 5 * MiB;
constexpr size_t WS_HC = 5 * MiB + 512 * 1024;
constexpr size_t WS_TOKE = 6 * MiB;
constexpr size_t WS_TOKP = 6 * MiB + 256 * 1024;
constexpr size_t WS_TOKG = 6 * MiB + 512 * 1024;
constexpr size_t WS_TLIST = 7 * MiB;
constexpr size_t WS_WIN = 10 * MiB;
constexpr size_t WS_WOUT = 34 * MiB;
constexpr size_t WS_WAX = 42 * MiB;
constexpr size_t WS_WGU = 44 * MiB;
constexpr size_t WS_WDN = 108 * MiB;
constexpr size_t WS_U = 140 * MiB;
constexpr size_t WS_A = 172 * MiB;
constexpr size_t WS_V = 236 * MiB;
constexpr size_t WS_O = 268 * MiB;
constexpr size_t WS_XR = 300 * MiB;
constexpr size_t WS_GR = 332 * MiB;
constexpr size_t WS_B = 364 * MiB;
constexpr size_t WS_UC = 428 * MiB;
constexpr size_t WS_HLOC = 460 * MiB;
constexpr size_t WS_PCUM = 492 * MiB;
constexpr size_t WS_XB = 524 * MiB;
constexpr size_t WS_END = 556 * MiB;
constexpr size_t WS_HID = WS_V;
constexpr size_t WS_YB = WS_V + 40 * MiB;
static_assert(WS_YB + (size_t)40960 * 1024 * 2 <= WS_B, "moe overlay");

constexpr int CW_BAR = 4096;
constexpr int CW_ADA = 2048;
constexpr int CW_TILE = 16384;
constexpr int CW_CNT = 8192;

constexpr int LDS_SCR = 143360;
constexpr int LDS_TT = 143360;
constexpr int LDS_MISC = 144896;
constexpr int LDS_BYTES = 147456;

__device__ __forceinline__ float bf2f(unsigned b) { return __uint_as_float(b << 16); }
__device__ __forceinline__ float bflo(unsigned w) { return __uint_as_float(w << 16); }
__device__ __forceinline__ float bfhi(unsigned w) { return __uint_as_float(w & 0xffff0000u); }
__device__ __forceinline__ unsigned f2bf(float f) { unsigned u = __float_as_uint(f); return (u + 0x7fffu + ((u >> 16) & 1u)) >> 16; }
typedef __bf16 bf16x2_t __attribute__((ext_vector_type(2)));
__device__ __forceinline__ unsigned pk2(float lo, float hi) { const f32x2 v = {lo, hi}; return __builtin_bit_cast(unsigned, __builtin_convertvector(v, bf16x2_t)); }
__device__ __forceinline__ float rbf(float f) { return bf2f(f2bf(f)); }
__device__ __forceinline__ float wave_sum(float v) {
#pragma unroll
    for (int o = 1; o < 64; o <<= 1) v += __shfl_xor(v, o);
    return v;
}
__device__ __forceinline__ float wave_max(float v) {
#pragma unroll
    for (int o = 1; o < 64; o <<= 1) v = fmaxf(v, __shfl_xor(v, o));
    return v;
}
__device__ __forceinline__ float fast_exp(float x) { return __builtin_amdgcn_exp2f(x * 1.4426950408889634f); }
__device__ __forceinline__ float fast_rcp(float x) { return __builtin_amdgcn_rcpf(x); }
__device__ __forceinline__ float sigmoid_f(float x) { return fast_rcp(1.f + fast_exp(-x)); }
__device__ __forceinline__ float silu_f(float x) { return x * fast_rcp(1.f + fast_exp(-x)); }
__device__ __forceinline__ float gelu_tanh_f(float x) { const float u = 0.7978845608f * (x + 0.044715f * x * x * x); const float t = 1.f - 2.f * fast_rcp(1.f + fast_exp(2.f * u)); return 0.5f * x * (1.f + t); }
__device__ __forceinline__ float logsigmoid_f(float x) { return fminf(x, 0.f) - log1pf(__expf(-fabsf(x))); }
__device__ __forceinline__ float softplus_f(float x) { return fmaxf(x, 0.f) + log1pf(__expf(-fabsf(x))); }

__device__ __forceinline__ void st16_wt(void* p, u32x4 v) { asm volatile("global_store_dwordx4 %0, %1, off sc1\n\ts_nop 1" :: "v"(p), "v"(v) : "memory"); }
__device__ __forceinline__ void st16_wt(void* p, f32x4 v) { asm volatile("global_store_dwordx4 %0, %1, off sc1\n\ts_nop 1" :: "v"(p), "v"(v) : "memory"); }

__device__ __forceinline__ void lds_barrier() { asm volatile("s_waitcnt lgkmcnt(0)" ::: "memory"); __builtin_amdgcn_s_barrier(); asm volatile("" ::: "memory"); }

template <int N> __device__ __forceinline__ float reduce_scatter(float (&v)[N], int lane) {
    if constexpr (N == 32) {
#pragma unroll
        for (int i = 0; i < 16; ++i) { const bool up = (lane & 32) != 0; const float send = up ? v[i] : v[i + 16]; const float recv = __shfl_xor(send, 32); v[i] = (up ? v[i + 16] : v[i]) + recv; }
    }
    constexpr int M0 = (N == 32) ? 16 : 32;
    {
#pragma unroll
        for (int i = 0; i < 8; ++i) { const bool up = (lane & M0) != 0; const float send = up ? v[i] : v[i + 8]; const float recv = __shfl_xor(send, M0); v[i] = (up ? v[i + 8] : v[i]) + recv; }
#pragma unroll
        for (int i = 0; i < 4; ++i) { const bool up = (lane & (M0 >> 1)) != 0; const float send = up ? v[i] : v[i + 4]; const float recv = __shfl_xor(send, M0 >> 1); v[i] = (up ? v[i + 4] : v[i]) + recv; }
#pragma unroll
        for (int i = 0; i < 2; ++i) { const bool up = (lane & (M0 >> 2)) != 0; const float send = up ? v[i] : v[i + 2]; const float recv = __shfl_xor(send, M0 >> 2); v[i] = (up ? v[i + 2] : v[i]) + recv; }
        { const bool up = (lane & (M0 >> 3)) != 0; const float send = up ? v[0] : v[1]; const float recv = __shfl_xor(send, M0 >> 3); v[0] = (up ? v[1] : v[0]) + recv; }
    }
    float r = v[0];
#pragma unroll
    for (int m = (M0 >> 4); m >= 1; m >>= 1) r += __shfl_xor(r, m);
    return r;
}

#define XB_TMO      128
#define XB_XCNT(j)  (256  + 64 * (j))
#define XB_XSUB(j)  (1280 + 64 * (j))
#define XB_XGEN(j)  (2304 + 64 * (j))
#define XB_TOP      3328
#define XB_TOPGEN   3392
#define XCD_BAR_WORDS 3456
#define XB_SPIN_CAP (1u << 18)

__device__ __forceinline__ unsigned xb_ld(unsigned* p)              { return __hip_atomic_load(p, __ATOMIC_RELAXED, __HIP_MEMORY_SCOPE_AGENT); }
__device__ __forceinline__ unsigned xb_add(unsigned* p, unsigned v) { return __hip_atomic_fetch_add(p, v, __ATOMIC_RELAXED, __HIP_MEMORY_SCOPE_AGENT); }
__device__ __forceinline__ unsigned xb_xcc_id() { return (unsigned)__builtin_amdgcn_s_getreg((3 << 11) | 20) & 0xFu; }
#define XB_SPIN(cond, bar) do { unsigned _sp = 0; while (cond) { __builtin_amdgcn_s_sleep(1); \
    if ((++_sp & 255u) == 0u) { if (xb_ld(&(bar)[XB_TMO])) break; if (_sp > XB_SPIN_CAP) { atomicAdd(&(bar)[XB_TMO], 1u); break; } } } } while (0)

struct XcdBarrier { unsigned* bar; unsigned x; volatile LAS unsigned* st; };

__device__ __forceinline__ XcdBarrier xcd_barrier_post(unsigned* bar, volatile LAS unsigned* st) {
    XcdBarrier b; b.bar = bar; b.x = xb_xcc_id(); b.st = st;
    if (threadIdx.x == 0) (void)xb_add(&bar[XB_XCNT(b.x)], 1u);
    return b;
}
__device__ __forceinline__ void xcd_barrier_complete(unsigned* bar, unsigned x, unsigned& nloc, unsigned& nx) {
    const unsigned G = gridDim.x * gridDim.y * gridDim.z;
    unsigned sum, cnt, mine, sp = 0u;
    for (;;) {
        sum = 0u; cnt = 0u; mine = 0u;
#pragma unroll
        for (unsigned j = 0; j < 16; ++j) { const unsigned c = xb_ld(&bar[XB_XCNT(j)]); sum += c; cnt += (c > 0u) ? 1u : 0u; mine = (j == x) ? c : mine; }
        if (sum == G) break;
        __builtin_amdgcn_s_sleep(1);
        if ((++sp & 255u) == 0u) { if (xb_ld(&bar[XB_TMO])) break; if (sp > XB_SPIN_CAP) { atomicAdd(&bar[XB_TMO], 1u); break; } }
    }
    nloc = mine > 0u ? mine : 1u; nx = cnt > 0u ? cnt : 1u;
}
__device__ __attribute__((noinline)) void xcd_barrier_impl(unsigned* bbar, unsigned bx, volatile LAS unsigned* bst) {
    XcdBarrier b; b.bar = bbar; b.x = bx; b.st = bst;
    asm volatile("s_waitcnt vmcnt(0)" ::: "memory");
    __syncthreads();
    if (threadIdx.x == 0) {
        unsigned* bar = b.bar;
        __builtin_amdgcn_s_waitcnt(0);
        unsigned nloc = b.st[0], nx = b.st[1];
        if (nloc == 0u) { xcd_barrier_complete(bar, b.x, nloc, nx); b.st[0] = nloc; b.st[1] = nx; }
        const unsigned old = xb_add(&bar[XB_XSUB(b.x)], 1u);
        const unsigned gen = old / nloc;
        if (old + 1u == (gen + 1u) * nloc) {
            __builtin_amdgcn_fence(__ATOMIC_RELEASE, "agent");
            asm volatile("s_waitcnt vmcnt(0)" ::: "memory");
            const unsigned og = xb_add(&bar[XB_TOP], 1u);
            const unsigned tg = og / nx;
            if (og + 1u == (tg + 1u) * nx) xb_add(&bar[XB_TOPGEN], 1u);
            else XB_SPIN(xb_ld(&bar[XB_TOPGEN]) == tg, bar);
            __builtin_amdgcn_fence(__ATOMIC_ACQUIRE, "agent");
            xb_add(&bar[XB_XGEN(b.x)], 1u);
            asm volatile("s_waitcnt vmcnt(0)" ::: "memory");
        } else {
            XB_SPIN(xb_ld(&bar[XB_XGEN(b.x)]) == gen, bar);
            __builtin_amdgcn_fence(__ATOMIC_ACQUIRE, "agent");
            asm volatile("s_waitcnt vmcnt(0)" ::: "memory");
        }
    }
    __syncthreads();
}

namespace pg8 {
constexpr int BM = 256, BK = 64, HALF = 128, HTB = HALF * BK * 2, STAGE_BYTES = 8 * HTB, NXCD = 8, WGM = 8;
__host__ __device__ __forceinline__ int lds_byte(int r, int c) { const int st = (r >> 4) * 2 + (c >> 5), rr = r & 15, cc = c & 31, ob = rr * 64 + cc * 2; return st * 1024 + (ob ^ (((ob >> 9) & 1) << 5)); }
__host__ __device__ __forceinline__ void stage_rc(int b, int& R, int& C) { const int st = b / 1024, sb = b % 1024, swz = sb ^ (((sb >> 9) & 1) << 5); R = (st >> 1) * 16 + swz / 64; C = (st & 1) * 32 + (swz % 64) / 2; }
__host__ __device__ __forceinline__ int perm32(int rho) { const int n = rho >> 4, i = rho & 15; return 8 * (i >> 2) + 4 * n + (i & 3); }

struct Unit { int pm, pn, e, j, half; };

struct DenseOrder {
    static constexpr bool HOOKS = false;
    int nM, nN, nwg, G, c;
    __device__ __forceinline__ void init(int M, int N, int G_, int c_) { nM = M / BM; nN = N / BM; nwg = nM * nN; G = G_; c = c_; }
    __device__ __forceinline__ bool next(int i, Unit& u) const {
        const long L = (long)i * G + c; if (L >= nwg) return false;
        int wgid = (int)L; { const int q = nwg / NXCD, r = nwg % NXCD, xcd = wgid % NXCD, off = wgid / NXCD; wgid = (xcd < r ? xcd * (q + 1) : r * (q + 1) + (xcd - r) * q) + off; }
        const int nig = WGM * nN, gid = wgid / nig, fm = gid * WGM, gsz = (nM - fm) < WGM ? (nM - fm) : WGM;
        u.pm = fm + ((wgid % nig) % gsz); u.pn = (wgid % nig) / gsz; u.e = 0; u.j = 0; u.half = 0; return true;
    }
    __device__ __forceinline__ size_t a_base(const Unit& u, int K) const { return (size_t)u.pm * 256 * K * 2; }
    __device__ __forceinline__ size_t b_base(const Unit& u, int K) const { return (size_t)u.pn * 256 * K * 2; }
    __device__ __forceinline__ void a_offs(const Unit&, int, const int (&)[2], const int (&)[2], unsigned (&)[4]) const {}
    __device__ __forceinline__ void a_ready(const Unit&, int) const {}
    __device__ __forceinline__ void done(int, int) const {}
};
struct MoeOrder {
    static constexpr bool HOOKS = true;
    const LAS int* tt;
    const int* tlist;
    int ntiles, G, c; size_t estrideB;
    __device__ __forceinline__ bool next(int i, Unit& u) const {
        const int L = i * G + c; if (L >= ntiles * 4) return false;
        const int tau = L >> 2; u.pn = L & 3; u.pm = tau; const int t = tt[65 + tau]; u.e = t >> 16; u.j = t & 0x7fff; u.half = (t >> 15) & 1; return true;
    }
    __device__ __forceinline__ size_t a_base(const Unit& u, int K) const { return (size_t)u.pm * 256 * K * 2; }
    __device__ __forceinline__ size_t b_base(const Unit& u, int K) const { return (size_t)u.e * estrideB + (size_t)u.pn * 256 * K * 2; }
    __device__ __forceinline__ void a_offs(const Unit& u, int K, const int (&R)[2], const int (&C)[2], unsigned (&o)[4]) const {
        const int cnt = tt[u.e];
#pragma unroll
        for (int h = 0; h < 2; ++h)
#pragma unroll
            for (int i = 0; i < 2; ++i) { const int idx = u.j * 256 + h * 128 + R[i]; int tok = 0; if (idx < cnt) tok = tlist[u.e * 16384 + idx]; o[h * 2 + i] = (unsigned)(tok * K + C[i]) * 2u; }
    }
    unsigned* tcnt; int mode;
    __device__ __forceinline__ void done(int pm, int lane) const {
        if (mode == 1 && lane == 0) __hip_atomic_fetch_add(tcnt + 16 * pm, 1u, __ATOMIC_RELAXED, __HIP_MEMORY_SCOPE_AGENT);
    }
    __device__ __forceinline__ void a_ready(const Unit& u, int wid) const {
        if (mode != 2) return;
        if (wid == 0) {
            unsigned sp = 0;
            while ((unsigned)__builtin_amdgcn_readfirstlane(__hip_atomic_load(tcnt + 16 * u.pm, __ATOMIC_RELAXED, __HIP_MEMORY_SCOPE_AGENT)) < 32u) { __builtin_amdgcn_s_sleep(2); if (++sp > (1u << 21)) break; }
            __builtin_amdgcn_fence(__ATOMIC_ACQUIRE, "agent");
            asm volatile("s_waitcnt vmcnt(0)" ::: "memory");
        }
        asm volatile("" ::: "memory"); __builtin_amdgcn_s_barrier(); asm volatile("" ::: "memory");
    }
};

__device__ __forceinline__ unsigned cvt_pk_bf16(float lo, float hi) { return pk2(lo, hi); }

struct EpiF32 {
    static constexpr bool PERM = false;
    float* C; int ldc;
    __device__ __forceinline__ void operator()(const f32x4 (&acc)[2][2][4][2], const Unit& u, int wr, int wc, int fr, int fq) const {
        const int row0 = u.pm * BM + wr * 64 + fr, col0 = u.pn * BM + wc * 32 + 4 * fq;
#pragma unroll
        for (int ai = 0; ai < 2; ++ai)
#pragma unroll
            for (int m = 0; m < 4; ++m) { float* rowp = C + (size_t)(row0 + ai * HALF + m * 16) * ldc + col0;
#pragma unroll
                for (int bj = 0; bj < 2; ++bj)
#pragma unroll
                    for (int n = 0; n < 2; ++n) st16_wt(rowp + bj * HALF + n * 16, acc[ai][bj][m][n]); }
    }
};
struct EpiProj {
    static constexpr bool PERM = true;
    bf16 *QK, *V, *O, *XR, *GR; const float* bias;
    __device__ __forceinline__ void operator()(const f32x4 (&acc)[2][2][4][2], const Unit& u, int wr, int wc, int fr, int fq) const {
        const int pn = u.pn; bf16* base; int ldc, colt, bcol, act;
        if (pn < 8) { base = QK; ldc = 2048; colt = pn * 256; bcol = pn * 256; act = 0; }
        else if (pn < 12) { base = V; ldc = 1024; colt = (pn - 8) * 256; bcol = pn * 256; act = 0; }
        else if (pn < 16) { base = O; ldc = 1024; colt = (pn - 12) * 256; bcol = pn * 256; act = 1; }
        else if (pn < 20) { base = XR; ldc = 1024; colt = (pn - 16) * 256; bcol = pn * 256 + 16; act = 0; }
        else { base = GR; ldc = 1024; colt = (pn - 20) * 256; bcol = pn * 256 + 16; act = 2; }
        const int row0 = u.pm * BM + wr * 64 + fr, col0 = colt + wc * 32 + 8 * fq, bcol0 = bcol + wc * 32 + 8 * fq;
        f32x4 bv[2][2];
#pragma unroll
        for (int bj = 0; bj < 2; ++bj)
#pragma unroll
            for (int n = 0; n < 2; ++n) bv[bj][n] = *(const f32x4*)(bias + bcol0 + bj * HALF + 4 * n);
#pragma unroll
        for (int ai = 0; ai < 2; ++ai)
#pragma unroll
            for (int m = 0; m < 4; ++m) { bf16* rowp = base + (size_t)(row0 + ai * HALF + m * 16) * ldc + col0;
#pragma unroll
                for (int bj = 0; bj < 2; ++bj) { f32x4 v0 = acc[ai][bj][m][0] + bv[bj][0], v1 = acc[ai][bj][m][1] + bv[bj][1];
                    if (act == 1) {
#pragma unroll
                        for (int q = 0; q < 4; ++q) { v0[q] = sigmoid_f(v0[q]); v1[q] = sigmoid_f(v1[q]); } }
                    if (act == 2) {
#pragma unroll
                        for (int q = 0; q < 4; ++q) { v0[q] = gelu_tanh_f(v0[q]); v1[q] = gelu_tanh_f(v1[q]); } }
                    u32x4 w; w.x = cvt_pk_bf16(v0[0], v0[1]); w.y = cvt_pk_bf16(v0[2], v0[3]); w.z = cvt_pk_bf16(v1[0], v1[1]); w.w = cvt_pk_bf16(v1[2], v1[3]);
                    st16_wt(rowp + bj * HALF, w); } }
    }
};
struct EpiHid {
    static constexpr bool PERM = true;
    bf16* H;
    __device__ __forceinline__ void operator()(const f32x4 (&acc)[2][2][4][2], const Unit& u, int wr, int wc, int fr, int fq) const {
        const int row0 = u.pm * BM + wr * 64 + fr, col0 = u.pn * 128 + wc * 32 + 8 * fq;
#pragma unroll
        for (int ai = 0; ai < 2; ++ai) { if (ai == 1 && u.half) break;
#pragma unroll
            for (int m = 0; m < 4; ++m) { bf16* rowp = H + (size_t)(row0 + ai * HALF + m * 16) * DFF + col0;
                f32x4 v0, v1;
#pragma unroll
                for (int q = 0; q < 4; ++q) { v0[q] = silu_f(acc[ai][0][m][0][q]) * acc[ai][1][m][0][q]; v1[q] = silu_f(acc[ai][0][m][1][q]) * acc[ai][1][m][1][q]; }
                u32x4 w; w.x = cvt_pk_bf16(v0[0], v0[1]); w.y = cvt_pk_bf16(v0[2], v0[3]); w.z = cvt_pk_bf16(v1[0], v1[1]); w.w = cvt_pk_bf16(v1[2], v1[3]);
                st16_wt(rowp, w); } }
    }
};
struct EpiBf16 {
    static constexpr bool PERM = true;
    bf16* O; int ldc;
    __device__ __forceinline__ void operator()(const f32x4 (&acc)[2][2][4][2], const Unit& u, int wr, int wc, int fr, int fq) const {
        const int row0 = u.pm * BM + wr * 64 + fr, col0 = u.pn * BM + wc * 32 + 8 * fq;
#pragma unroll
        for (int ai = 0; ai < 2; ++ai) { if (ai == 1 && u.half) break;
#pragma unroll
            for (int m = 0; m < 4; ++m) { bf16* rowp = O + (size_t)(row0 + ai * HALF + m * 16) * ldc + col0;
#pragma unroll
                for (int bj = 0; bj < 2; ++bj) { const f32x4 v0 = acc[ai][bj][m][0], v1 = acc[ai][bj][m][1];
                    u32x4 w; w.x = cvt_pk_bf16(v0[0], v0[1]); w.y = cvt_pk_bf16(v0[2], v0[3]); w.z = cvt_pk_bf16(v1[0], v1[1]); w.w = cvt_pk_bf16(v1[2], v1[3]);
                    st16_wt(rowp + bj * HALF, w); } } }
    }
};

template <class Epi, class Sched, bool GATHER, bool ALIGN_EPI>
__device__ __forceinline__ void gemm_phase(LAS unsigned char* lds, const bf16* Aptr, const bf16* Bptr, const int K, const Sched& S, const Epi& E, const int tid) {
    const int wid = __builtin_amdgcn_readfirstlane(tid >> 6), lane = tid & 63, wr = wid >> 2, wc = wid & 3, fr = lane & 15, fq = lane >> 4;
    const int nt = K / BK;
    unsigned voffA[2], voffB[2]; int RA[2], CA[2];
#pragma unroll
    for (int i = 0; i < 2; ++i) { int R, C; stage_rc(tid * 16 + i * 8192, R, C); const int Rb = Epi::PERM ? ((R & ~31) + perm32(R & 31)) : R;
        voffA[i] = (unsigned)(R * K + C) * 2u; voffB[i] = (unsigned)(Rb * K + C) * 2u; RA[i] = R; CA[i] = C; }
    const size_t kstep = (size_t)(BK * 2);
    const size_t hstep = (size_t)HALF * K * 2;
    const unsigned ldsw = (unsigned)wid * 1024u;
    const int aoff = lds_byte(wr * 64 + fr, fq * 8), boff = lds_byte(wc * 32 + fr, fq * 8);
#define PG8_SA(b, h) (((b) * 2 + (h)) * HTB)
#define PG8_SB(b, h) ((4 + (b) * 2 + (h)) * HTB)
#define PG8_GLDS(src, dstoff) __builtin_amdgcn_global_load_lds((const unsigned*)(src), (LAS unsigned*)(lds + (dstoff)), 16, 0, 0)
#define PG8_STAGE_B(bufoff, gbase) do { _Pragma("unroll") for (int _i = 0; _i < 2; ++_i) PG8_GLDS((const char*)(gbase) + voffB[_i], (bufoff) + ldsw + _i * 8192); } while (0)
#define PG8_STAGE_A(bufoff, gbase, h, OFF) do { if constexpr (GATHER) { _Pragma("unroll") for (int _i = 0; _i < 2; ++_i) PG8_GLDS((const char*)(gbase) + OFF[(h) * 2 + _i], (bufoff) + ldsw + _i * 8192); } \
        else { _Pragma("unroll") for (int _i = 0; _i < 2; ++_i) PG8_GLDS((const char*)(gbase) + (h) * hstep + voffA[_i], (bufoff) + ldsw + _i * 8192); } } while (0)
#define PG8_LDA(dst, b, h) do { _Pragma("unroll") for (int m = 0; m < 4; ++m) _Pragma("unroll") for (int k = 0; k < 2; ++k) dst[m][k] = *(const LAS bf16x8*)(lds + PG8_SA(b, h) + aoff + m * 2048 + k * 1024); } while (0)
#define PG8_LDB(dst, b, h) do { _Pragma("unroll") for (int n = 0; n < 2; ++n) _Pragma("unroll") for (int k = 0; k < 2; ++k) dst[n][k] = *(const LAS bf16x8*)(lds + PG8_SB(b, h) + boff + n * 2048 + k * 1024); } while (0)
#define PG8_MMA(ai, bj, At, Bt) do { __builtin_amdgcn_s_setprio(1); _Pragma("unroll") for (int m = 0; m < 4; ++m) _Pragma("unroll") for (int n = 0; n < 2; ++n) _Pragma("unroll") for (int k = 0; k < 2; ++k) \
        acc[ai][bj][m][n] = __builtin_amdgcn_mfma_f32_16x16x32_bf16(Bt[n][k], At[m][k], acc[ai][bj][m][n], 0, 0, 0); __builtin_amdgcn_s_setprio(0); } while (0)
#define PG8_WAIT_V(n) asm volatile("s_waitcnt vmcnt(" #n ")" ::: "memory")
#define PG8_WAIT_L(n) asm volatile("s_waitcnt lgkmcnt(" #n ")" ::: "memory")
#define PG8_BAR __builtin_amdgcn_s_barrier()
#define PG8_SCHED __builtin_amdgcn_sched_barrier(0)
    Unit cur, nxt; int ui = 0;
    if (!S.next(0, cur)) return;
    f32x4 acc[2][2][4][2];
#pragma unroll
    for (int a = 0; a < 2; ++a)
#pragma unroll
        for (int b = 0; b < 2; ++b)
#pragma unroll
            for (int m = 0; m < 4; ++m)
#pragma unroll
                for (int n = 0; n < 2; ++n) acc[a][b][m][n] = (f32x4){0.f, 0.f, 0.f, 0.f};
    bf16x8 At[4][2], B0[2][2], B1[2][2];
    unsigned offA[4] = {0u, 0u, 0u, 0u}, noffA[4] = {0u, 0u, 0u, 0u};
    const char* cA = GATHER ? (const char*)Aptr : (const char*)Aptr + S.a_base(cur, K);
    const char* cB = (const char*)Bptr + S.b_base(cur, K);
    if constexpr (GATHER) S.a_offs(cur, K, RA, CA, offA);
    if constexpr (Sched::HOOKS) S.a_ready(cur, wid);
    int pend_pm = -1;
    PG8_STAGE_B(PG8_SB(0, 0), cB); PG8_STAGE_B(PG8_SB(0, 1), cB + hstep); PG8_STAGE_A(PG8_SA(0, 0), cA, 0, offA); PG8_STAGE_A(PG8_SA(0, 1), cA, 1, offA);
    if (wr == 1) PG8_BAR;
    PG8_WAIT_V(2); PG8_BAR;
    PG8_STAGE_B(PG8_SB(1, 0), cB + kstep); PG8_STAGE_A(PG8_SA(1, 0), cA + kstep, 0, offA); PG8_STAGE_B(PG8_SB(1, 1), cB + hstep + kstep);
    PG8_WAIT_V(6); PG8_BAR;
    for (;;) {
        const bool has_next = S.next(ui + 1, nxt);
        const char* nA = cA; const char* nB = cB;
        if (has_next) { nA = GATHER ? (const char*)Aptr : (const char*)Aptr + S.a_base(nxt, K); nB = (const char*)Bptr + S.b_base(nxt, K); }
        if constexpr (GATHER) { if (has_next) S.a_offs(nxt, K, RA, CA, noffA); else {
#pragma unroll
            for (int q = 0; q < 4; ++q) noffA[q] = offA[q]; } }
        for (int t = 0; t < nt; t += 2) {
            const bool last = (t == nt - 2);
            if (t == 2 && pend_pm >= 0) { S.done(pend_pm, lane); pend_pm = -1; }
            if (last && has_next) S.a_ready(nxt, wid);
            const char* a1 = cA + (size_t)(t + 1) * kstep;
            const char* a2 = last ? nA : cA + (size_t)(t + 2) * kstep; const char* b2 = last ? nB : cB + (size_t)(t + 2) * kstep;
            const char* a3 = a2 + kstep; const char* b3 = b2 + kstep;
            unsigned o2[4];
#pragma unroll
            for (int q = 0; q < 4; ++q) o2[q] = last ? noffA[q] : offA[q];
            PG8_LDB(B0, 0, 0); PG8_LDB(B1, 0, 1); PG8_SCHED; PG8_LDA(At, 0, 0); PG8_STAGE_A(PG8_SA(1, 1), a1, 1, offA);
            PG8_WAIT_V(8); PG8_WAIT_L(0); PG8_BAR; PG8_MMA(0, 0, At, B0); PG8_MMA(0, 1, At, B1); PG8_BAR; PG8_SCHED;
            PG8_LDA(At, 0, 1); PG8_STAGE_B(PG8_SB(0, 0), b2); PG8_STAGE_B(PG8_SB(0, 1), b2 + hstep); PG8_STAGE_A(PG8_SA(0, 0), a2, 0, o2);
            PG8_WAIT_V(8); PG8_WAIT_L(0); PG8_BAR; if (!(Sched::HOOKS && cur.half)) { PG8_MMA(1, 0, At, B0); PG8_MMA(1, 1, At, B1); } PG8_BAR; PG8_SCHED;
            PG8_LDB(B0, 1, 0); PG8_LDB(B1, 1, 1); PG8_SCHED; PG8_LDA(At, 1, 0); PG8_STAGE_A(PG8_SA(0, 1), a2, 1, o2);
            PG8_WAIT_V(8); PG8_WAIT_L(0); PG8_BAR; PG8_MMA(0, 0, At, B0); PG8_MMA(0, 1, At, B1); PG8_BAR; PG8_SCHED;
            PG8_LDA(At, 1, 1); PG8_STAGE_B(PG8_SB(1, 0), b3); PG8_STAGE_B(PG8_SB(1, 1), b3 + hstep); PG8_STAGE_A(PG8_SA(1, 0), a3, 0, o2);
            PG8_WAIT_V(8); PG8_WAIT_L(0); PG8_BAR; if (!(Sched::HOOKS && cur.half)) { PG8_MMA(1, 0, At, B0); PG8_MMA(1, 1, At, B1); } PG8_BAR; PG8_SCHED;
        }
        if constexpr (ALIGN_EPI) { if (wr == 0) PG8_BAR; }
        E(acc, cur, wr, wc, fr, fq);
        if constexpr (Sched::HOOKS) pend_pm = cur.pm;
        if (!has_next) break;
#pragma unroll
        for (int a = 0; a < 2; ++a)
#pragma unroll
            for (int b = 0; b < 2; ++b)
#pragma unroll
                for (int m = 0; m < 4; ++m)
#pragma unroll
                    for (int n = 0; n < 2; ++n) acc[a][b][m][n] = (f32x4){0.f, 0.f, 0.f, 0.f};
        cur = nxt; cA = nA; cB = nB; ++ui;
#pragma unroll
        for (int q = 0; q < 4; ++q) offA[q] = noffA[q];
        if constexpr (ALIGN_EPI) { if (wr == 1) PG8_BAR; }
    }
    PG8_WAIT_V(0);
    if constexpr (Sched::HOOKS) { if (pend_pm >= 0) S.done(pend_pm, lane); }
    if constexpr (!ALIGN_EPI) { if (wr == 0) PG8_BAR; }
    PG8_BAR;
#undef PG8_SA
#undef PG8_SB
#undef PG8_GLDS
#undef PG8_STAGE_A
#undef PG8_STAGE_B
#undef PG8_LDA
#undef PG8_LDB
#undef PG8_MMA
#undef PG8_WAIT_V
#undef PG8_WAIT_L
#undef PG8_BAR
#undef PG8_SCHED
}
}

struct Args { const float* in[25]; float* out; unsigned char* ws; int ph_lo, ph_hi, pflags, pad; };
enum { I_X = 0, I_C, I_WADA, I_BADA, I_WIN, I_BIN, I_WCM, I_BCM, I_MHG, I_WCR, I_BCR, I_WA, I_BA, I_WX, I_BX, I_LAM, I_LRUG, I_WOUT, I_WR, I_BR, I_WG, I_WU, I_WD, I_LNG, I_LNB };

struct Frame {
    LAS unsigned char* lds;
    int tid, lane, wave, G, bid, zoff, pflags;
    const float* const* in; float* out; unsigned char* ws;
};

__device__ __forceinline__ void transpose_item(const float* W, int ldn, bf16* WT, int ldk, int k0, int n0, int drow0, LAS float* scr, int lane) {
#pragma unroll 8
    for (int i = 0; i < 32; ++i) { const int kk = 2 * i + (lane >> 5); scr[kk * 33 + (lane & 31)] = W[(size_t)(k0 + kk) * ldn + n0 + (lane & 31)]; }
    asm volatile("s_waitcnt lgkmcnt(0)" ::: "memory");
    const int c = lane & 7;
#pragma unroll
    for (int j = 0; j < 4; ++j) { const int n = (lane >> 3) + 8 * j; const LAS float* s = scr + (8 * c) * 33 + n;
        u32x4 o; o.x = pk2(s[0 * 33], s[1 * 33]); o.y = pk2(s[2 * 33], s[3 * 33]); o.z = pk2(s[4 * 33], s[5 * 33]); o.w = pk2(s[6 * 33], s[7 * 33]);
        *(u32x4*)(WT + (size_t)(drow0 + n) * ldk + k0 + 8 * c) = o; }
    asm volatile("s_waitcnt lgkmcnt(0)" ::: "memory");
}
__device__ __forceinline__ void conv_dense_item(const Frame& F, int it, LAS float* scr) {
    const int l = it / 4224; int r = it % 4224;
    const float* w_in = F.in[(I_WIN) + F.zoff] + (size_t)l * D * NIN;
    bf16* WIN = (bf16*)(F.ws + WS_WIN) + (size_t)l * NPROJ * D;
    if (r < 2048) { const int kb = r / 128, nb = r % 128; transpose_item(w_in, NIN, WIN, D, kb * 64, nb * 32, nb * 32, scr, F.lane); return; }
    r -= 2048;
    if (r < 1024) { const int kb = r / 64, nb = r % 64; transpose_item(w_in + 4112, NIN, WIN, D, kb * 64, nb * 32, 4096 + nb * 32, scr, F.lane); return; }
    r -= 1024;
    if (r < 1024) { const int kb = r / 32, nb = r % 32; transpose_item(F.in[(I_WOUT) + F.zoff] + (size_t)l * 2048 * 1024, 1024, (bf16*)(F.ws + WS_WOUT) + (size_t)l * 1024 * 2048, 2048, kb * 64, nb * 32, nb * 32, scr, F.lane); return; }
    r -= 1024;
    { const int which = r / 64; r %= 64; const int kb = r / 4, nb = r % 4;
      transpose_item(F.in[(which ? I_WX : I_WA) + F.zoff] + (size_t)l * 8 * 128 * 128, 128, (bf16*)(F.ws + WS_WAX) + (size_t)(l * 2 + which) * 128 * 1024, 1024, kb * 64, nb * 32, nb * 32, scr, F.lane); }
}
__device__ __forceinline__ void conv_moe_item(const Frame& F, int l, int it, LAS float* scr) {
    const int e = it / 768; int r = it % 768;
    if (r < 512) { const int which = r / 256; r %= 256; const int kb = r / 16, nb = r % 16, n0 = nb * 32, drow = (n0 / 128) * 256 + which * 128 + (n0 % 128);
        transpose_item(F.in[(which ? I_WU : I_WG) + F.zoff] + (size_t)(l * NE + e) * D * DFF, DFF, (bf16*)(F.ws + WS_WGU) + (size_t)e * 1024 * 1024, 1024, kb * 64, n0, drow, scr, F.lane); return; }
    r -= 512;
    { const int kb = r / 32, nb = r % 32; transpose_item(F.in[(I_WD) + F.zoff] + (size_t)(l * NE + e) * DFF * D, D, (bf16*)(F.ws + WS_WDN) + (size_t)e * 1024 * 512, 512, kb * 64, nb * 32, nb * 32, scr, F.lane); }
}

__device__ __forceinline__ void ln_row(f32x4 (&v)[4]) {
    float s = 0.f;
#pragma unroll
    for (int j = 0; j < 4; ++j) s += (v[j].x + v[j].y) + (v[j].z + v[j].w);
    const float mean = wave_sum(s) * (1.f / D); float s2 = 0.f;
#pragma unroll
    for (int j = 0; j < 4; ++j) { v[j] = v[j] - mean; s2 += (v[j].x * v[j].x + v[j].y * v[j].y) + (v[j].z * v[j].z + v[j].w * v[j].w); }
    const float rstd = __builtin_amdgcn_rsqf(wave_sum(s2) * (1.f / D) + LN_EPS);
#pragma unroll
    for (int j = 0; j < 4; ++j) v[j] = v[j] * rstd;
}
__device__ __forceinline__ void emit_u(const Frame& F, f32x4 (&v)[4], const LAS float* sh, const LAS float* sc1p, int row, const LAS float* Wif, const float* bif) {
    bf16* U_ = (bf16*)(F.ws + WS_U); float* IFG_ = (float*)(F.ws + WS_IFG);
    const int lane = F.lane;
#pragma unroll
    for (int j = 0; j < 4; ++j) { const f32x4 a = *(const LAS f32x4*)(sc1p + 256 * j + 4 * lane), b = *(const LAS f32x4*)(sh + 256 * j + 4 * lane); v[j] = v[j] * a + b;
        u32x2 w; w.x = pk2(v[j].x, v[j].y); w.y = pk2(v[j].z, v[j].w); *(u32x2*)(U_ + (size_t)row * D + 256 * j + 4 * lane) = w; }
    float part[16];
#pragma unroll
    for (int q = 0; q < 16; ++q) { float p = 0.f;
#pragma unroll
        for (int j = 0; j < 4; ++j) { const f32x4 w = *(const LAS f32x4*)(Wif + q * 1024 + 256 * j + 4 * lane); p += (v[j].x * w.x + v[j].y * w.y) + (v[j].z * w.z + v[j].w * w.w); }
        part[q] = p; if (q & 1) asm volatile("" ::: "memory"); }
    const float tot = reduce_scatter<16>(part, lane);
    if ((lane & 3) == 0) { const int q = lane >> 2; IFG_[(size_t)row * 16 + q] = tot + bif[q]; }
}
__device__ __forceinline__ void load_wif(const Frame& F, int l, LAS float* Wif) {
    const float* w_in = F.in[(I_WIN) + F.zoff] + (size_t)l * D * NIN + 4096;
    for (int i = F.tid; i < 16 * 1024; i += 512) { const int k = i >> 4, q = i & 15; Wif[q * 1024 + k] = w_in[(size_t)k * NIN + q]; }
}

__device__ __forceinline__ int build_tile_table(const Frame& F, int l) {
    LAS int* tt = (LAS int*)(F.lds + LDS_TT);
    const unsigned* cnt = (const unsigned*)(F.ws + WS_CTL) + CW_CNT + l * 2048;
    __syncthreads();
    if (F.tid < 32) tt[F.tid] = (int)cnt[64 * F.tid];
    __syncthreads();
    if (F.tid == 0) { int b = 0;
#pragma unroll 1
        for (int e = 0; e < 32; ++e) { tt[32 + e] = b; const int cnt_e = tt[e], n = (cnt_e + 255) >> 8; const int lastrows = cnt_e - ((n - 1) << 8);
            const int nbig = (n > 0 && lastrows <= 128) ? n - 1 : n; tt[225 + e] = nbig;
            for (int j = 0; j < nbig; ++j) tt[65 + b + j] = (e << 16) | j; b += nbig; }
#pragma unroll 1
        for (int e = 0; e < 32; ++e) { const int cnt_e = tt[e], n = (cnt_e + 255) >> 8; tt[257 + e] = b;
            if (n > tt[225 + e]) { tt[65 + b] = (e << 16) | (1 << 15) | (n - 1); b += 1; } }
        tt[64] = b; }
    __syncthreads();
    return tt[64];
}


#define Ub    ((bf16*)(ws + WS_U))
#define QKpre ((bf16*)(ws + WS_A))
#define Yb    ((bf16*)(ws + WS_A))
#define Vb    ((bf16*)(ws + WS_V))
#define Ob    ((bf16*)(ws + WS_O))
#define XRb   ((bf16*)(ws + WS_XR))
#define GRb   ((bf16*)(ws + WS_GR))
#define Qb    ((bf16*)(ws + WS_B))
#define Kb    ((bf16*)(ws + WS_B) + (size_t)S * D)
#define YO    ((bf16*)(ws + WS_B))
#define XB    ((bf16*)(ws + WS_XB))
#define UC    ((bf16*)(ws + WS_UC))
#define HLOC  ((bf16*)(ws + WS_HLOC))
#define PCUM  ((bf16*)(ws + WS_PCUM))
#define IFG   ((float*)(ws + WS_IFG))
#define BCUM  ((float*)(ws + WS_BCUM))
#define CHS   ((float*)(ws + WS_CHS))
#define MST   ((float*)(ws + WS_MST))
#define NLOC  ((float*)(ws + WS_NLOC))
#define NST   ((float*)(ws + WS_NST))
#define AC    ((float*)(ws + WS_AC))
#define HC    ((float*)(ws + WS_HC))
#define TOKE  ((int*)(ws + WS_TOKE))
#define TOKP  ((int*)(ws + WS_TOKP))
#define TOKG  ((float*)(ws + WS_TOKG))
#define TLIST ((int*)(ws + WS_TLIST))
#define HID   ((bf16*)(ws + WS_HID))
#define YB    ((bf16*)(ws + WS_YB))
#define ADA   ((float*)(ws + WS_ADA))
#define ada   (ADA + l * 6144)
#define ECNT  ((unsigned*)(ws + WS_CTL) + CW_CNT + l * 2048)
#define PH_BEGIN() int zoff; asm volatile("s_mov_b32 %0, 0" : "=s"(zoff)); unsigned char* ws = args.ws + zoff; F.zoff = zoff; F.ws = ws; \
    int tid = threadIdx.x; asm volatile("" : "+v"(tid)); const int lane = tid & 63; const int wave = __builtin_amdgcn_readfirstlane(tid >> 6); \
    int G = gridDim.x; asm volatile("" : "+s"(G)); int bid = blockIdx.x; asm volatile("" : "+s"(bid)); \
    F.tid = tid; F.lane = lane; F.wave = wave; F.G = G; F.bid = bid; const int gw = bid * 8 + wave, NGW = G * 8; (void)gw; (void)NGW; (void)lane

typedef short s16x4 __attribute__((ext_vector_type(4)));
__device__ __forceinline__ bf16x8 tr_read2(const LAS bf16* p0, const LAS bf16* p1) {
    const s16x4 a = __builtin_amdgcn_ds_read_tr16_b64_v4i16((LAS s16x4*)p0), b = __builtin_amdgcn_ds_read_tr16_b64_v4i16((LAS s16x4*)p1);
    bf16x8 r; r[0] = a[0]; r[1] = a[1]; r[2] = a[2]; r[3] = a[3]; r[4] = b[0]; r[5] = b[1]; r[6] = b[2]; r[7] = b[3]; return r;
}
__device__ __forceinline__ f32x4 mfma16(bf16x8 a, bf16x8 b, f32x4 c) { return __builtin_amdgcn_mfma_f32_16x16x32_bf16(a, b, c, 0, 0, 0); }

__device__ __forceinline__ void phaseC_mlstm(const Frame& F, unsigned char* ws, int l, int c, int h) {
    const int tid = F.tid, lane = F.lane, wave = F.wave, zoff = F.zoff;
    constexpr int KP = 136, VP = 152;
    LAS bf16* Ks = (LAS bf16*)(F.lds); LAS bf16* Vs = (LAS bf16*)(F.lds + 34816); LAS float* wgt = (LAS float*)(F.lds + 73728);
    if (wave == 0) {
        const int t0 = 2 * lane; const size_t s0 = (size_t)c * CH + t0;
        const float i0 = IFG[s0 * 16 + h], i1 = IFG[(s0 + 1) * 16 + h], f0 = IFG[s0 * 16 + 8 + h], f1 = IFG[(s0 + 1) * 16 + 8 + h];
        const float l0 = logsigmoid_f(f0), l1 = logsigmoid_f(f1);
        const float pair = l0 + l1; float incl = pair;
#pragma unroll
        for (int o = 1; o < 64; o <<= 1) { const float t = __shfl_up(incl, o); if (lane >= o) incl += t; }
        const float b0 = incl - pair + l0, b1 = incl;
        const float blast = __shfl(incl, 63);
        const float g0 = blast - b0 + i0, g1 = blast - b1 + i1;
        const float a = wave_max(fmaxf(g0, g1));
        wgt[t0] = __expf(g0 - a); wgt[t0 + 1] = __expf(g1 - a);
        BCUM[s0 * 8 + h] = b0; BCUM[(s0 + 1) * 8 + h] = b1;
        if (lane == 0) { CHS[(c * 8 + h) * 2] = blast; CHS[(c * 8 + h) * 2 + 1] = a; }
    }
    const int cg = tid & 15, rq = tid >> 4;
#pragma unroll 1
    for (int which = 0; which < 2; ++which) {
        const int col = which * 1024 + h * 128 + cg * 8;
        float w[4][8], bsv[8], xv[7][8];
        const float* wc_ = F.in[(I_WCM) + zoff] + (size_t)l * 4 * 2048 + col;
#pragma unroll
        for (int k = 0; k < 4; ++k) { const f32x4 a = *(const f32x4*)(wc_ + k * 2048), b = *(const f32x4*)(wc_ + k * 2048 + 4); w[k][0] = a.x; w[k][1] = a.y; w[k][2] = a.z; w[k][3] = a.w; w[k][4] = b.x; w[k][5] = b.y; w[k][6] = b.z; w[k][7] = b.w; }
        { const float* bp = F.in[(I_BCM) + zoff] + (size_t)l * 2048 + col; const f32x4 a = *(const f32x4*)bp, b = *(const f32x4*)(bp + 4); bsv[0] = a.x; bsv[1] = a.y; bsv[2] = a.z; bsv[3] = a.w; bsv[4] = b.x; bsv[5] = b.y; bsv[6] = b.z; bsv[7] = b.w; }
#pragma unroll
        for (int i = 0; i < 7; ++i) { const int s = c * CH + rq * 4 - 3 + i; u32x4 raw = {0u, 0u, 0u, 0u}; if (s >= 0) raw = *(const u32x4*)(QKpre + (size_t)s * 2048 + col);
            xv[i][0] = bflo(raw.x); xv[i][1] = bfhi(raw.x); xv[i][2] = bflo(raw.y); xv[i][3] = bfhi(raw.y); xv[i][4] = bflo(raw.z); xv[i][5] = bfhi(raw.z); xv[i][6] = bflo(raw.w); xv[i][7] = bfhi(raw.w); }
#pragma unroll
        for (int rr = 0; rr < 4; ++rr) { float y[8];
#pragma unroll
            for (int j = 0; j < 8; ++j) { float a = bsv[j];
#pragma unroll
                for (int k = 0; k < 4; ++k) a += w[k][j] * xv[rr + k][j];
                a = silu_f(a); if (which) a *= 0.08838834764831845f; y[j] = a; }
            u32x4 o; o.x = pk2(y[0], y[1]); o.y = pk2(y[2], y[3]); o.z = pk2(y[4], y[5]); o.w = pk2(y[6], y[7]);
            const size_t srow = (size_t)c * CH + rq * 4 + rr;
            *(u32x4*)((which ? Kb : Qb) + srow * D + h * 128 + cg * 8) = o;
            if (which) *(LAS u32x4*)(Ks + (rq * 4 + rr) * KP + cg * 8) = o;
        }
    }
    __syncthreads();
#pragma unroll
    for (int rr = 0; rr < 4; ++rr) { const int r = rq * 4 + rr; const u32x4 raw = *(const u32x4*)(Vb + ((size_t)c * CH + r) * D + h * 128 + cg * 8); const float wg = wgt[r];
        u32x4 o; o.x = pk2(bflo(raw.x) * wg, bfhi(raw.x) * wg); o.y = pk2(bflo(raw.y) * wg, bfhi(raw.y) * wg); o.z = pk2(bflo(raw.z) * wg, bfhi(raw.z) * wg); o.w = pk2(bflo(raw.w) * wg, bfhi(raw.w) * wg);
        *(LAS u32x4*)(Vs + r * VP + cg * 8) = o;
        if (cg == 0) { u32x4 e0 = {f2bf(wg), 0u, 0u, 0u}, e1 = {0u, 0u, 0u, 0u}; *(LAS u32x4*)(Vs + r * VP + 128) = e0; *(LAS u32x4*)(Vs + r * VP + 136) = e1; } }
    __syncthreads();
    {
        const int g = lane >> 4, li = lane & 15, rsub = li >> 2, csub = 4 * (li & 3);
        bf16x8 af[4];
#pragma unroll
        for (int ks = 0; ks < 4; ++ks) af[ks] = tr_read2(Ks + (32 * ks + 8 * g + rsub) * KP + 16 * wave + csub, Ks + (32 * ks + 8 * g + 4 + rsub) * KP + 16 * wave + csub);
#pragma unroll
        for (int et = 0; et < 9; ++et) {
            f32x4 acc = {0.f, 0.f, 0.f, 0.f};
#pragma unroll
            for (int ks = 0; ks < 4; ++ks) { const bf16x8 bfr = tr_read2(Vs + (32 * ks + 8 * g + rsub) * VP + 16 * et + csub, Vs + (32 * ks + 8 * g + 4 + rsub) * VP + 16 * et + csub); acc = mfma16(af[ks], bfr, acc); }
            if (et < 8) { u32x2 o; o.x = pk2(acc[0], acc[1]); o.y = pk2(acc[2], acc[3]); *(u32x2*)(UC + ((size_t)(c * 8 + h) * 128 + 16 * et + li) * 128 + 16 * wave + 4 * g) = o; }
            else if (li == 0) *(f32x4*)(NLOC + (c * 8 + h) * 128 + 16 * wave + 4 * g) = acc;
        }
    }
    __syncthreads();
}

__device__ __forceinline__ void phaseC_lru(const Frame& F, unsigned char* ws, int l, int c, int n) {
    const int tid = F.tid, lane = F.lane, wave = F.wave, zoff = F.zoff;
    constexpr int XP = 136;
    LAS bf16* Xc = (LAS bf16*)(F.lds); LAS bf16* Was = (LAS bf16*)(F.lds + 34816); LAS bf16* Wxs = (LAS bf16*)(F.lds + 69632); LAS float* ex = (LAS float*)(F.lds + 104448);
    LAS bf16* Hst = Was; LAS bf16* Pst = Wxs;
    {
        const int cg = tid & 15, rq = tid >> 4; const int col = n * 128 + cg * 8;
        float w[4][8], bsv[8], xv[7][8];
        const float* wc_ = F.in[(I_WCR) + zoff] + (size_t)l * 4 * 1024 + col;
#pragma unroll
        for (int k = 0; k < 4; ++k) { const f32x4 a = *(const f32x4*)(wc_ + k * 1024), b = *(const f32x4*)(wc_ + k * 1024 + 4); w[k][0] = a.x; w[k][1] = a.y; w[k][2] = a.z; w[k][3] = a.w; w[k][4] = b.x; w[k][5] = b.y; w[k][6] = b.z; w[k][7] = b.w; }
        { const float* bp = F.in[(I_BCR) + zoff] + (size_t)l * 1024 + col; const f32x4 a = *(const f32x4*)bp, b = *(const f32x4*)(bp + 4); bsv[0] = a.x; bsv[1] = a.y; bsv[2] = a.z; bsv[3] = a.w; bsv[4] = b.x; bsv[5] = b.y; bsv[6] = b.z; bsv[7] = b.w; }
#pragma unroll
        for (int i = 0; i < 7; ++i) { const int s = c * CH + rq * 4 - 3 + i; u32x4 raw = {0u, 0u, 0u, 0u}; if (s >= 0) raw = *(const u32x4*)(XRb + (size_t)s * D + col);
            xv[i][0] = bflo(raw.x); xv[i][1] = bfhi(raw.x); xv[i][2] = bflo(raw.y); xv[i][3] = bfhi(raw.y); xv[i][4] = bflo(raw.z); xv[i][5] = bfhi(raw.z); xv[i][6] = bflo(raw.w); xv[i][7] = bfhi(raw.w); }
#pragma unroll
        for (int rr = 0; rr < 4; ++rr) { float y[8];
#pragma unroll
            for (int j = 0; j < 8; ++j) { float a = bsv[j];
#pragma unroll
                for (int k = 0; k < 4; ++k) a += w[k][j] * xv[rr + k][j];
                y[j] = a; }
            u32x4 o; o.x = pk2(y[0], y[1]); o.y = pk2(y[2], y[3]); o.z = pk2(y[4], y[5]); o.w = pk2(y[6], y[7]);
            *(LAS u32x4*)(Xc + (rq * 4 + rr) * XP + cg * 8) = o; }
        const bf16* wax = (const bf16*)(ws + WS_WAX) + (size_t)(l * 2) * 128 * 1024 + n * 128;
#pragma unroll
        for (int it = 0; it < 4; ++it) { const int i = tid + it * 512, dout = i >> 4, c8 = i & 15;
            *(LAS u32x4*)(Was + dout * XP + c8 * 8) = *(const u32x4*)(wax + (size_t)dout * 1024 + c8 * 8);
            *(LAS u32x4*)(Wxs + dout * XP + c8 * 8) = *(const u32x4*)(wax + (size_t)128 * 1024 + (size_t)dout * 1024 + c8 * 8); }
    }
    __syncthreads();
    const int g = lane >> 4, li = lane & 15;
    f32x4 aP[8], aH[8];
    {
        bf16x8 af[4];
#pragma unroll
        for (int ks = 0; ks < 4; ++ks) af[ks] = *(const LAS bf16x8*)(Xc + (16 * wave + li) * XP + 32 * ks + 8 * g);
#pragma unroll
        for (int nt = 0; nt < 8; ++nt) {
            f32x4 a0 = {0.f, 0.f, 0.f, 0.f}, a1 = {0.f, 0.f, 0.f, 0.f};
#pragma unroll
            for (int ks = 0; ks < 4; ++ks) { a0 = mfma16(af[ks], *(const LAS bf16x8*)(Was + (16 * nt + li) * XP + 32 * ks + 8 * g), a0); a1 = mfma16(af[ks], *(const LAS bf16x8*)(Wxs + (16 * nt + li) * XP + 32 * ks + 8 * g), a1); }
            aP[nt] = a0; aH[nt] = a1;
        }
    }
    float gP[8], gH[8];
#pragma unroll
    for (int nt = 0; nt < 8; ++nt) {
        const int ch = n * 128 + 16 * nt + li;
        const float ba = F.in[(I_BA) + zoff][l * 1024 + ch], bx = F.in[(I_BX) + zoff][l * 1024 + ch];
        const float sp = softplus_f(-F.in[(I_LAM) + zoff][l * 1024 + ch]);
        float hh = 0.f, pp = 1.f;
#pragma unroll
        for (int r = 0; r < 4; ++r) {
            const float xcv = bf2f(Xc[(16 * wave + 4 * g + r) * XP + 16 * nt + li]);
            const float rgate = sigmoid_f(aP[nt][r] + ba), ig = sigmoid_f(aH[nt][r] + bx);
            const float la = -8.0f * rgate * sp; const float a = fast_exp(la);
            const float xin = __builtin_amdgcn_sqrtf(1.0f - a * a) * (ig * xcv);
            hh = a * hh + xin; pp = pp * a; aP[nt][r] = pp; aH[nt][r] = hh;
        }
        const float p0 = __shfl(pp, li), p1 = __shfl(pp, li + 16), p2 = __shfl(pp, li + 32), p3 = __shfl(pp, li + 48);
        const float h0 = __shfl(hh, li), h1 = __shfl(hh, li + 16), h2 = __shfl(hh, li + 32), h3 = __shfl(hh, li + 48);
        float cP = 1.f, cH = 0.f;
        if (g > 0) { cH = p0 * cH + h0; cP = cP * p0; }
        if (g > 1) { cH = p1 * cH + h1; cP = cP * p1; }
        if (g > 2) { cH = p2 * cH + h2; cP = cP * p2; }
        gP[nt] = cP; gH[nt] = cH;
        if (g == 0) { float wP = p0, wH = h0; wH = p1 * wH + h1; wP *= p1; wH = p2 * wH + h2; wP *= p2; wH = p3 * wH + h3; wP *= p3;
            ex[(wave * 128 + 16 * nt + li) * 2] = wP; ex[(wave * 128 + 16 * nt + li) * 2 + 1] = wH; }
    }
    __syncthreads();
#pragma unroll
    for (int nt = 0; nt < 8; ++nt) {
        float wP = 1.f, wH = 0.f;
        for (int ww = 0; ww < wave; ++ww) { const float P = ex[(ww * 128 + 16 * nt + li) * 2], Hh = ex[(ww * 128 + 16 * nt + li) * 2 + 1]; wH = P * wH + Hh; wP = wP * P; }
        const float cH = gP[nt] * wH + gH[nt], cP = gP[nt] * wP;
#pragma unroll
        for (int r = 0; r < 4; ++r) { const float hf = aH[nt][r] + aP[nt][r] * cH, pf = aP[nt][r] * cP; const int sl = 16 * wave + 4 * g + r;
            Hst[sl * XP + 16 * nt + li] = (bf16)f2bf(hf); Pst[sl * XP + 16 * nt + li] = (bf16)f2bf(pf);
            if (wave == 7 && g == 3 && r == 3) { AC[c * 1024 + n * 128 + 16 * nt + li] = pf; HC[c * 1024 + n * 128 + 16 * nt + li] = hf; } }
    }
    __syncthreads();
#pragma unroll
    for (int it = 0; it < 4; ++it) { const int i = tid + it * 512, row = i >> 4, c8 = i & 15; const size_t gofs = ((size_t)c * CH + row) * D + n * 128 + c8 * 8;
        *(u32x4*)(HLOC + gofs) = *(const LAS u32x4*)(Hst + row * XP + c8 * 8); *(u32x4*)(PCUM + gofs) = *(const LAS u32x4*)(Pst + row * XP + c8 * 8); }
    __syncthreads();
}

__device__ __forceinline__ void phaseE_all(const Frame& F, unsigned char* ws, const int l) {
    const int tid = F.tid, lane = F.lane, wave = F.wave, zoff = F.zoff, G = F.G, bid = F.bid;
    constexpr int EP = 136;
    LAS bf16* Ks = (LAS bf16*)(F.lds); LAS bf16* Vs = (LAS bf16*)(F.lds + 34816); LAS bf16* Cs = (LAS bf16*)(F.lds + 69632);
    LAS float* wsv = (LAS float*)(F.lds + 108800); LAS float* Mt = wsv + 128; LAS float* bt = wsv + 256;
    LAS float* cwq = (LAS float*)(F.lds + 110336);
    u32x4 kt[4], vt[4], ct[4]; float nstv = 0.f, sb0 = 0.f, sb1 = 0.f, si0 = 0.f, si1 = 0.f, smp = 0.f;
#define E_LOAD(UNIT) do { const int c_ = (UNIT) >> 3, h_ = (UNIT) & 7; \
        _Pragma("unroll") for (int it = 0; it < 4; ++it) { const int i = tid + it * 512, r = i >> 4, cg = i & 15; const size_t gofs = ((size_t)c_ * CH + r) * D + h_ * 128 + cg * 8; \
            kt[it] = *(const u32x4*)(Kb + gofs); vt[it] = *(const u32x4*)(Vb + gofs); ct[it] = *(const u32x4*)(UC + (size_t)(c_ * 8 + h_) * 16384 + (size_t)i * 8); } \
        if (tid < 128) nstv = NST[(c_ * 8 + h_) * 128 + tid]; \
        if (wave == 1) { const size_t s0_ = (size_t)c_ * CH + 2 * lane; sb0 = BCUM[s0_ * 8 + h_]; sb1 = BCUM[(s0_ + 1) * 8 + h_]; si0 = IFG[s0_ * 16 + h_]; si1 = IFG[(s0_ + 1) * 16 + h_]; smp = MST[c_ * 8 + h_]; } } while (0)
    int hcur = -1;
    int unit = bid;
    if (unit < NC * 8) E_LOAD(unit);
#pragma unroll 1
    for (; unit < NC * 8; unit += G) {
        const int c = unit >> 3, h = unit & 7;
        if (h != hcur) { lds_barrier();
            for (int i = tid; i < 640; i += 512) { const int k5 = i >> 7, col = i & 127; cwq[i] = (k5 < 4) ? F.in[(I_WCM) + zoff][(size_t)l * 4 * 2048 + k5 * 2048 + h * 128 + col] : F.in[(I_BCM) + zoff][(size_t)l * 2048 + h * 128 + col]; }
            hcur = h; }
        u32x4 qraw[4][4];
        {
            const int tq = 16 * wave + (lane & 15);
#pragma unroll
            for (int ks = 0; ks < 4; ++ks)
#pragma unroll
                for (int k = 0; k < 4; ++k) { const int srow = c * CH + tq - 3 + k; qraw[ks][k] = (u32x4){0u, 0u, 0u, 0u}; if (srow >= 0) qraw[ks][k] = *(const u32x4*)(QKpre + (size_t)srow * 2048 + h * 128 + 32 * ks + 8 * (lane >> 4)); }
        }
#pragma unroll
        for (int it = 0; it < 4; ++it) { const int i = tid + it * 512, r = i >> 4, cg = i & 15;
            *(LAS u32x4*)(Ks + r * EP + cg * 8) = kt[it]; *(LAS u32x4*)(Vs + r * EP + cg * 8) = vt[it];
            { const u32x4 cv = ct[it];
              const int pos = i * 2, L = pos & 63, wv = (pos >> 6) & 7, et = pos >> 9, gg = L >> 4, ll = L & 15;
              u32x2 c0; c0.x = cv.x; c0.y = cv.y; u32x2 c1; c1.x = cv.z; c1.y = cv.w;
              *(LAS u32x2*)(Cs + (16 * et + ll) * EP + 16 * wv + 4 * gg) = c0; *(LAS u32x2*)(Cs + (16 * et + ll + 1) * EP + 16 * wv + 4 * gg) = c1; } }
        if (tid < 128) { const unsigned hi = f2bf(nstv); Cs[128 * EP + tid] = (bf16)hi; Cs[129 * EP + tid] = (bf16)f2bf(nstv - bf2f(hi)); }
        float mprev_u = 0.f;
        if (wave == 1) {
            const int t0 = 2 * lane;
            const float w0 = si0 - sb0, w1 = si1 - sb1;
            const float pm = fmaxf(w0, w1); float incl = pm;
#pragma unroll
            for (int o = 1; o < 64; o <<= 1) { const float t = __shfl_up(incl, o); if (lane >= o) incl = fmaxf(incl, t); }
            float excl = __shfl_up(incl, 1); if (lane == 0) excl = -3.0e38f;
            wsv[t0] = w0; wsv[t0 + 1] = w1; bt[t0] = sb0; bt[t0 + 1] = sb1;
            Mt[t0] = fmaxf(fmaxf(excl, w0), smp); Mt[t0 + 1] = fmaxf(incl, smp);
            if (lane == 0) cwq[640] = smp;
        }
        (void)mprev_u;
        lds_barrier();
        if (unit + G < NC * 8) E_LOAD(unit + G);
        {
            const int g = lane >> 4, li = lane & 15, t = 16 * wave + li;
            bf16x8 qf[4];
    #pragma unroll
            for (int ks = 0; ks < 4; ++ks) {
                u32x4 raw[4];
    #pragma unroll
                for (int k = 0; k < 4; ++k) raw[k] = qraw[ks][k];
                float y[8];
                { const f32x4 b0 = *(const LAS f32x4*)(cwq + 4 * 128 + 32 * ks + 8 * g), b1 = *(const LAS f32x4*)(cwq + 4 * 128 + 32 * ks + 8 * g + 4);
                  y[0] = b0.x; y[1] = b0.y; y[2] = b0.z; y[3] = b0.w; y[4] = b1.x; y[5] = b1.y; y[6] = b1.z; y[7] = b1.w; }
    #pragma unroll
                for (int k = 0; k < 4; ++k) { const f32x4 w0 = *(const LAS f32x4*)(cwq + k * 128 + 32 * ks + 8 * g), w1 = *(const LAS f32x4*)(cwq + k * 128 + 32 * ks + 8 * g + 4);
                    y[0] += w0.x * bflo(raw[k].x); y[1] += w0.y * bfhi(raw[k].x); y[2] += w0.z * bflo(raw[k].y); y[3] += w0.w * bfhi(raw[k].y);
                    y[4] += w1.x * bflo(raw[k].z); y[5] += w1.y * bfhi(raw[k].z); y[6] += w1.z * bflo(raw[k].w); y[7] += w1.w * bfhi(raw[k].w); }
                u32x4 pq; pq.x = pk2(silu_f(y[0]), silu_f(y[1])); pq.y = pk2(silu_f(y[2]), silu_f(y[3])); pq.z = pk2(silu_f(y[4]), silu_f(y[5])); pq.w = pk2(silu_f(y[6]), silu_f(y[7]));
                qf[ks] = __builtin_bit_cast(bf16x8, pq);
            }
            const float Mtt = Mt[t]; float dsum = 0.f;
            unsigned pk[8][2];
    #pragma unroll
            for (int st = 0; st < 8; ++st) {
                pk[st][0] = 0u; pk[st][1] = 0u;
                if (st <= wave) {
                    f32x4 sa = {0.f, 0.f, 0.f, 0.f};
    #pragma unroll
                    for (int ks = 0; ks < 4; ++ks) sa = mfma16(*(const LAS bf16x8*)(Ks + (16 * st + li) * EP + 32 * ks + 8 * g), qf[ks], sa);
                    const f32x4 w4 = *(const LAS f32x4*)(wsv + 16 * st + 4 * g);
                    float v[4];
    #pragma unroll
                    for (int r = 0; r < 4; ++r) { const int s = 16 * st + 4 * g + r; v[r] = (s <= t) ? sa[r] * __expf(w4[r] - Mtt) : 0.f; dsum += v[r]; }
                    pk[st][0] = pk2(v[0], v[1]); pk[st][1] = pk2(v[2], v[3]);
                }
            }
            dsum += __shfl_xor(dsum, 16); dsum += __shfl_xor(dsum, 32);
            f32x4 nacc[8];
    #pragma unroll
            for (int et = 0; et < 8; ++et) nacc[et] = (f32x4){0.f, 0.f, 0.f, 0.f};
            const int rsub = li >> 2, csub = 4 * (li & 3);
    #pragma unroll
            for (int kp = 0; kp < 4; ++kp) {
                if (2 * kp <= wave) {
                    u32x4 pw = {pk[2 * kp][0], pk[2 * kp][1], pk[2 * kp + 1][0], pk[2 * kp + 1][1]};
                    const bf16x8 pf = __builtin_bit_cast(bf16x8, pw);
    #pragma unroll
                    for (int et = 0; et < 8; ++et) { const bf16x8 vf = tr_read2(Vs + (32 * kp + 4 * g + rsub) * EP + 16 * et + csub, Vs + (32 * kp + 16 + 4 * g + rsub) * EP + 16 * et + csub); nacc[et] = mfma16(vf, pf, nacc[et]); }
                }
            }
            f32x4 iacc[9];
    #pragma unroll
            for (int et = 0; et < 9; ++et) { f32x4 a = {0.f, 0.f, 0.f, 0.f};
    #pragma unroll
                for (int ks = 0; ks < 4; ++ks) a = mfma16(*(const LAS bf16x8*)(Cs + (16 * et + li) * EP + 32 * ks + 8 * g), qf[ks], a);
                iacc[et] = a; }
            float dint = iacc[8][0] + iacc[8][1]; dint = __shfl(dint, li);
            const float winter = __expf(cwq[640] - Mtt);
            const float den = dsum + winter * dint;
            const float dn = fmaxf(fabsf(den), __expf(-(bt[t] + Mtt)));
            const float inv = 1.f / dn;
            float sm = 0.f;
    #pragma unroll
            for (int et = 0; et < 8; ++et) { nacc[et] = (nacc[et] + iacc[et] * winter) * inv; sm += (nacc[et][0] + nacc[et][1]) + (nacc[et][2] + nacc[et][3]); }
            sm += __shfl_xor(sm, 16); sm += __shfl_xor(sm, 32);
            const float mean = sm * (1.f / 128.f); float s2 = 0.f;
    #pragma unroll
            for (int et = 0; et < 8; ++et) { nacc[et] = nacc[et] - mean; s2 += (nacc[et][0] * nacc[et][0] + nacc[et][1] * nacc[et][1]) + (nacc[et][2] * nacc[et][2] + nacc[et][3] * nacc[et][3]); }
            s2 += __shfl_xor(s2, 16); s2 += __shfl_xor(s2, 32);
            const float rstd = __builtin_amdgcn_rsqf(s2 * (1.f / 128.f) + LN_EPS);
            const size_t srow = (size_t)c * CH + t; const float* mg = F.in[(I_MHG) + zoff] + l * 1024 + h * 128 + 4 * g;
    #pragma unroll
            for (int et = 0; et < 8; ++et) { const u32x2 o2 = *(const u32x2*)(Ob + srow * D + h * 128 + 16 * et + 4 * g); const f32x4 gm = *(const f32x4*)(mg + 16 * et);
                u32x2 w; w.x = pk2(nacc[et][0] * rstd * bflo(o2.x) * gm.x, nacc[et][1] * rstd * bfhi(o2.x) * gm.y); w.y = pk2(nacc[et][2] * rstd * bflo(o2.y) * gm.z, nacc[et][3] * rstd * bfhi(o2.y) * gm.w);
                *(u32x2*)(Yb + srow * 2048 + h * 128 + 16 * et + 4 * g) = w; }
        }

        lds_barrier();
    }
#undef E_LOAD
}

__device__ __forceinline__ void phaseC_mlstm_all(const Frame& F, unsigned char* ws, const int l) {
    const int tid = F.tid, lane = F.lane, wave = F.wave, zoff = F.zoff, G = F.G, bid = F.bid;
    constexpr int KP = 136, VP = 152;
    LAS bf16* Ks = (LAS bf16*)(F.lds); LAS bf16* Vs = (LAS bf16*)(F.lds + 34816); LAS float* wgt = (LAS float*)(F.lds + 73728);
    LAS float* cw = (LAS float*)(F.lds + 74240);
    const int cg = tid & 15, rq = tid >> 4;
    u32x4 rk_[7], rv_[4]; float gi0 = 0.f, gi1 = 0.f, gf0 = 0.f, gf1 = 0.f;
    int hcur = -1;
#define C_LOAD(UNIT) do { const int c_ = (UNIT) >> 3, h_ = (UNIT) & 7; \
        _Pragma("unroll") for (int i = 0; i < 7; ++i) { const int s_ = c_ * CH + rq * 4 - 3 + i; rk_[i] = (u32x4){0u, 0u, 0u, 0u}; \
            if (s_ >= 0) rk_[i] = *(const u32x4*)(QKpre + (size_t)s_ * 2048 + 1024 + h_ * 128 + cg * 8); } \
        _Pragma("unroll") for (int rr = 0; rr < 4; ++rr) rv_[rr] = *(const u32x4*)(Vb + ((size_t)c_ * CH + rq * 4 + rr) * D + h_ * 128 + cg * 8); \
        if (wave == 0) { const size_t s0_ = (size_t)c_ * CH + 2 * lane; gi0 = IFG[s0_ * 16 + h_]; gi1 = IFG[(s0_ + 1) * 16 + h_]; gf0 = IFG[s0_ * 16 + 8 + h_]; gf1 = IFG[(s0_ + 1) * 16 + 8 + h_]; } } while (0)
    int unit = bid;
    if (unit < NC * 8) C_LOAD(unit);
#pragma unroll 1
    for (; unit < NC * 8; unit += G) {
        const int c = unit >> 3, h = unit & 7;
        if (h != hcur) {
            lds_barrier();
            for (int i = tid; i < 640; i += 512) { const int k5 = i >> 7, col = i & 127;
                cw[i] = (k5 < 4) ? F.in[(I_WCM) + zoff][(size_t)l * 4 * 2048 + k5 * 2048 + 1024 + h * 128 + col] : F.in[(I_BCM) + zoff][(size_t)l * 2048 + 1024 + h * 128 + col]; }
            hcur = h; lds_barrier();
        }
        if (wave == 0) {
            const int t0 = 2 * lane; const size_t s0 = (size_t)c * CH + t0;
            const float l0 = logsigmoid_f(gf0), l1 = logsigmoid_f(gf1);
            const float pair = l0 + l1; float incl = pair;
#pragma unroll
            for (int o = 1; o < 64; o <<= 1) { const float t = __shfl_up(incl, o); if (lane >= o) incl += t; }
            const float b0 = incl - pair + l0, b1 = incl;
            const float blast = __shfl(incl, 63);
            const float g0 = blast - b0 + gi0, g1 = blast - b1 + gi1;
            const float a = wave_max(fmaxf(g0, g1));
            wgt[t0] = __expf(g0 - a); wgt[t0 + 1] = __expf(g1 - a);
            BCUM[s0 * 8 + h] = b0; BCUM[(s0 + 1) * 8 + h] = b1;
            if (lane == 0) { CHS[(c * 8 + h) * 2] = blast; CHS[(c * 8 + h) * 2 + 1] = a; }
        }
        {
            float w[5][8];
#pragma unroll
            for (int k = 0; k < 5; ++k) { const f32x4 a = *(const LAS f32x4*)(cw + k * 128 + cg * 8), b = *(const LAS f32x4*)(cw + k * 128 + cg * 8 + 4);
                w[k][0] = a.x; w[k][1] = a.y; w[k][2] = a.z; w[k][3] = a.w; w[k][4] = b.x; w[k][5] = b.y; w[k][6] = b.z; w[k][7] = b.w; }
            float xv[7][8];
#pragma unroll
            for (int i = 0; i < 7; ++i) { const u32x4 raw = rk_[i];
                xv[i][0] = bflo(raw.x); xv[i][1] = bfhi(raw.x); xv[i][2] = bflo(raw.y); xv[i][3] = bfhi(raw.y); xv[i][4] = bflo(raw.z); xv[i][5] = bfhi(raw.z); xv[i][6] = bflo(raw.w); xv[i][7] = bfhi(raw.w); }
#pragma unroll
            for (int rr = 0; rr < 4; ++rr) { float y[8];
#pragma unroll
                for (int j = 0; j < 8; ++j) { float a = w[4][j];
#pragma unroll
                    for (int k = 0; k < 4; ++k) a += w[k][j] * xv[rr + k][j];
                    y[j] = silu_f(a) * 0.08838834764831845f; }
                u32x4 o; o.x = pk2(y[0], y[1]); o.y = pk2(y[2], y[3]); o.z = pk2(y[4], y[5]); o.w = pk2(y[6], y[7]);
                const size_t srow = (size_t)c * CH + rq * 4 + rr;
                *(u32x4*)(Kb + srow * D + h * 128 + cg * 8) = o;
                *(LAS u32x4*)(Ks + (rq * 4 + rr) * KP + cg * 8) = o;
            }
        }
        u32x4 vcur[4];
#pragma unroll
        for (int rr = 0; rr < 4; ++rr) vcur[rr] = rv_[rr];
        lds_barrier();
        if (unit + G < NC * 8) C_LOAD(unit + G);
#pragma unroll
        for (int rr = 0; rr < 4; ++rr) { const int r = rq * 4 + rr; const u32x4 raw = vcur[rr]; const float wg = wgt[r];
            u32x4 o; o.x = pk2(bflo(raw.x) * wg, bfhi(raw.x) * wg); o.y = pk2(bflo(raw.y) * wg, bfhi(raw.y) * wg); o.z = pk2(bflo(raw.z) * wg, bfhi(raw.z) * wg); o.w = pk2(bflo(raw.w) * wg, bfhi(raw.w) * wg);
            *(LAS u32x4*)(Vs + r * VP + cg * 8) = o;
            if (cg == 0) { u32x4 e0 = {f2bf(wg), 0u, 0u, 0u}, e1 = {0u, 0u, 0u, 0u}; *(LAS u32x4*)(Vs + r * VP + 128) = e0; *(LAS u32x4*)(Vs + r * VP + 136) = e1; } }
        lds_barrier();
        {
            const int g = lane >> 4, li = lane & 15, rsub = li >> 2, csub = 4 * (li & 3);
            bf16x8 af[4];
#pragma unroll
            for (int ks = 0; ks < 4; ++ks) af[ks] = tr_read2(Ks + (32 * ks + 8 * g + rsub) * KP + 16 * wave + csub, Ks + (32 * ks + 8 * g + 4 + rsub) * KP + 16 * wave + csub);
#pragma unroll
            for (int et = 0; et < 9; ++et) {
                f32x4 acc = {0.f, 0.f, 0.f, 0.f};
#pragma unroll
                for (int ks = 0; ks < 4; ++ks) { const bf16x8 bfr = tr_read2(Vs + (32 * ks + 8 * g + rsub) * VP + 16 * et + csub, Vs + (32 * ks + 8 * g + 4 + rsub) * VP + 16 * et + csub); acc = mfma16(af[ks], bfr, acc); }
                if (et < 8) { u32x2 o; o.x = pk2(acc[0], acc[1]); o.y = pk2(acc[2], acc[3]); *(u32x2*)(UC + (size_t)(c * 8 + h) * 16384 + ((et * 8 + wave) * 64 + lane) * 4) = o; }
                else if (li == 0) *(f32x4*)(NLOC + (c * 8 + h) * 128 + 16 * wave + 4 * g) = acc;
            }
        }
        lds_barrier();
    }
#undef C_LOAD
}

__device__ __forceinline__ void bcast4(float x, float& t0, float& t1, float& t2, float& t3) {
    const unsigned u = __float_as_uint(x);
    const auto s = __builtin_amdgcn_permlane16_swap(u, u, false, false);
    const auto a = __builtin_amdgcn_permlane32_swap(s[0], s[0], false, false);
    const auto b = __builtin_amdgcn_permlane32_swap(s[1], s[1], false, false);
    t0 = __uint_as_float(a[0]); t2 = __uint_as_float(a[1]); t1 = __uint_as_float(b[0]); t3 = __uint_as_float(b[1]);
}

__device__ __forceinline__ void phaseC_lru_all(const Frame& F, unsigned char* ws, const int l) {
    const int tid = F.tid, lane = F.lane, wave = F.wave, zoff = F.zoff, G = F.G, bid = F.bid;
    constexpr int XP = 136;
    LAS bf16* Xc = (LAS bf16*)(F.lds); LAS bf16* Hst = (LAS bf16*)(F.lds + 34816); LAS bf16* Pst = (LAS bf16*)(F.lds + 69632); LAS float* cwr = (LAS float*)(F.lds + 104448);
    const int cg = tid & 15, rq = tid >> 4, g = lane >> 4, li = lane & 15;
    u32x4 rx_[7];
    bf16x8 wa[4], wx[4]; float ba = 0.f, bx = 0.f, sp = 0.f;
    int ncur = -1;
#define L_LOAD(UNIT) do { const int c_ = (UNIT) >> 3, n_ = (UNIT) & 7; \
        _Pragma("unroll") for (int i = 0; i < 7; ++i) { const int s_ = c_ * CH + rq * 4 - 3 + i; rx_[i] = (u32x4){0u, 0u, 0u, 0u}; if (s_ >= 0) rx_[i] = *(const u32x4*)(XRb + (size_t)s_ * D + n_ * 128 + cg * 8); } } while (0)
    int unit = bid;
    if (unit < NC * 8) L_LOAD(unit);
#pragma unroll 1
    for (; unit < NC * 8; unit += G) {
        const int c = unit >> 3, n = unit & 7;
        if (n != ncur) {
            lds_barrier();
            for (int i = tid; i < 640; i += 512) { const int k5 = i >> 7, col = i & 127; cwr[i] = (k5 < 4) ? F.in[(I_WCR) + zoff][(size_t)l * 4 * 1024 + k5 * 1024 + n * 128 + col] : F.in[(I_BCR) + zoff][(size_t)l * 1024 + n * 128 + col]; }
            const bf16* wax = (const bf16*)(ws + WS_WAX) + (size_t)(l * 2) * 128 * 1024 + (size_t)(16 * wave + li) * 1024 + n * 128 + 8 * g;
#pragma unroll
            for (int ks = 0; ks < 4; ++ks) { wa[ks] = *(const bf16x8*)(wax + 32 * ks); wx[ks] = *(const bf16x8*)(wax + (size_t)128 * 1024 + 32 * ks); }
            const int ch = n * 128 + 16 * wave + li;
            ba = F.in[(I_BA) + zoff][l * 1024 + ch]; bx = F.in[(I_BX) + zoff][l * 1024 + ch]; sp = softplus_f(-F.in[(I_LAM) + zoff][l * 1024 + ch]);
            ncur = n; lds_barrier();
        }
        {
            float w[5][8];
#pragma unroll
            for (int k = 0; k < 5; ++k) { const f32x4 a = *(const LAS f32x4*)(cwr + k * 128 + cg * 8), b = *(const LAS f32x4*)(cwr + k * 128 + cg * 8 + 4);
                w[k][0] = a.x; w[k][1] = a.y; w[k][2] = a.z; w[k][3] = a.w; w[k][4] = b.x; w[k][5] = b.y; w[k][6] = b.z; w[k][7] = b.w; }
            float xv[7][8];
#pragma unroll
            for (int i = 0; i < 7; ++i) { const u32x4 raw = rx_[i];
                xv[i][0] = bflo(raw.x); xv[i][1] = bfhi(raw.x); xv[i][2] = bflo(raw.y); xv[i][3] = bfhi(raw.y); xv[i][4] = bflo(raw.z); xv[i][5] = bfhi(raw.z); xv[i][6] = bflo(raw.w); xv[i][7] = bfhi(raw.w); }
#pragma unroll
            for (int rr = 0; rr < 4; ++rr) { float y[8];
#pragma unroll
                for (int j = 0; j < 8; ++j) { float a = w[4][j];
#pragma unroll
                    for (int k = 0; k < 4; ++k) a += w[k][j] * xv[rr + k][j];
                    y[j] = a; }
                u32x4 o; o.x = pk2(y[0], y[1]); o.y = pk2(y[2], y[3]); o.z = pk2(y[4], y[5]); o.w = pk2(y[6], y[7]);
                *(LAS u32x4*)(Xc + (rq * 4 + rr) * XP + cg * 8) = o; }
        }
        lds_barrier();
        if (unit + G < NC * 8) L_LOAD(unit + G);
        f32x4 aA[8], aX[8];
#pragma unroll
        for (int tile = 0; tile < 8; ++tile) {
            f32x4 a0 = {0.f, 0.f, 0.f, 0.f}, a1 = {0.f, 0.f, 0.f, 0.f};
#pragma unroll
            for (int ks = 0; ks < 4; ++ks) { const bf16x8 af = *(const LAS bf16x8*)(Xc + (16 * tile + li) * XP + 32 * ks + 8 * g); a0 = mfma16(af, wa[ks], a0); a1 = mfma16(af, wx[ks], a1); }
            aA[tile] = a0; aX[tile] = a1;
        }
        float cP = 1.f, cH = 0.f;
        if (!(F.pflags & 128)) {
#pragma unroll
        for (int tile = 0; tile < 8; ++tile) {
            float hh = 0.f, pp = 1.f; float Pl[4], Hl[4];
#pragma unroll
            for (int r = 0; r < 4; ++r) {
                const float xcv = bf2f(Xc[(16 * tile + 4 * g + r) * XP + 16 * wave + li]);
                const float rgate = sigmoid_f(aA[tile][r] + ba), ig = sigmoid_f(aX[tile][r] + bx);
                const float la = -8.0f * rgate * sp; const float a = fast_exp(la);
                const float xin = __builtin_amdgcn_sqrtf(1.0f - a * a) * (ig * xcv);
                hh = a * hh + xin; pp = pp * a; Pl[r] = pp; Hl[r] = hh;
            }
            float p0, p1, p2, p3, h0, h1, h2, h3;
            bcast4(pp, p0, p1, p2, p3); bcast4(hh, h0, h1, h2, h3);
            float eP = cP, eH = cH;
            if (g > 0) { eH = p0 * eH + h0; eP = eP * p0; }
            if (g > 1) { eH = p1 * eH + h1; eP = eP * p1; }
            if (g > 2) { eH = p2 * eH + h2; eP = eP * p2; }
            if (!(F.pflags & 64)) {
#pragma unroll
            for (int r = 0; r < 4; ++r) { const int sl = 16 * tile + 4 * g + r;
                Hst[sl * XP + 16 * wave + li] = (bf16)f2bf(Hl[r] + Pl[r] * eH); Pst[sl * XP + 16 * wave + li] = (bf16)f2bf(Pl[r] * eP); }
            }
            cH = p0 * cH + h0; cP = cP * p0; cH = p1 * cH + h1; cP = cP * p1; cH = p2 * cH + h2; cP = cP * p2; cH = p3 * cH + h3; cP = cP * p3;
        }
        }
        if (g == 0) { AC[c * 1024 + n * 128 + 16 * wave + li] = cP; HC[c * 1024 + n * 128 + 16 * wave + li] = cH; }
        lds_barrier();
        if (!(F.pflags & 64)) {
#pragma unroll
        for (int it = 0; it < 4; ++it) { const int i = tid + it * 512, row = i >> 4, c8 = i & 15; const size_t gofs = ((size_t)c * CH + row) * D + n * 128 + c8 * 8;
            *(u32x4*)(HLOC + gofs) = *(const LAS u32x4*)(Hst + row * XP + c8 * 8); *(u32x4*)(PCUM + gofs) = *(const LAS u32x4*)(Pst + row * XP + c8 * 8); }
        }
    }
    lds_barrier();
#undef L_LOAD
}

static __device__ __forceinline__ void run_gemm_proj(LAS unsigned char* lds, unsigned char* ws, const float* bias, int l, int G, int bid, int tid) {
    pg8::DenseOrder So; So.init(S, NPROJ, G, bid);
    pg8::EpiProj E{QKpre, Vb, Ob, XRb, GRb, bias};
    pg8::gemm_phase<pg8::EpiProj, pg8::DenseOrder, false, true>(lds, Ub, (const bf16*)(ws + WS_WIN) + (size_t)l * NPROJ * D, D, So, E, tid);
}
static __device__ __forceinline__ void run_gemm_out(LAS unsigned char* lds, unsigned char* ws, int l, int G, int bid, int tid) {
    pg8::DenseOrder So; So.init(S, D, G, bid);
    pg8::EpiBf16 E{YO, D};
    pg8::gemm_phase<pg8::EpiBf16, pg8::DenseOrder, false, false>(lds, Yb, (const bf16*)(ws + WS_WOUT) + (size_t)l * 1024 * 2048, 2048, So, E, tid);
}
static __device__ __forceinline__ void run_gemm_gu(LAS unsigned char* lds, unsigned char* ws, unsigned* tcnt, int ntiles, int G, int bid, int tid) {
    pg8::MoeOrder So; So.tt = (const LAS int*)(lds + LDS_TT); So.tlist = TLIST; So.ntiles = ntiles; So.G = G; So.c = bid; So.estrideB = (size_t)1024 * 1024 * 2; So.tcnt = tcnt; So.mode = 1;
    pg8::EpiHid E{HID};
    pg8::gemm_phase<pg8::EpiHid, pg8::MoeOrder, true, true>(lds, Ub, (const bf16*)(ws + WS_WGU), D, So, E, tid);
}
static __device__ __forceinline__ void run_gemm_dn(LAS unsigned char* lds, unsigned char* ws, unsigned* tcnt, int ntiles, int G, int bid, int tid) {
    pg8::MoeOrder So; So.tt = (const LAS int*)(lds + LDS_TT); So.tlist = TLIST; So.ntiles = ntiles; So.G = G; So.c = bid; So.estrideB = (size_t)1024 * 512 * 2; So.tcnt = tcnt; So.mode = 2;
    pg8::EpiBf16 E{YB, D};
    pg8::gemm_phase<pg8::EpiBf16, pg8::MoeOrder, false, true>(lds, HID, (const bf16*)(ws + WS_WDN), DFF, So, E, tid);
}
#ifndef PH_MASK
#define PH_MASK 0xFFF
#endif
#define EN(b) (((PH_MASK) >> (b)) & 1)
#ifndef REPEAT_MASK
#define REPEAT_MASK 0
#endif
#define REPS(b) (1 + (((REPEAT_MASK) >> (b)) & 1))
#define IN(k) (lo <= (k) && (k) < hi && !(args.pflags & 256))
#define INS(k) (lo <= (k) && (k) < hi)
#define SEAM(k) do { if (INS(k) && INS((k) + 1)) { xcd_barrier_impl(bar.bar, bar.x, bar.st); } } while (0)


template <int L> __device__ __forceinline__ void layer_phases(const Args& args, Frame& F, const XcdBarrier& bar, const int lo, const int hi) {
    constexpr int l = L;
        const int pb = 2 + 9 * l;

        for (int rep_ = 0; rep_ < REPS(2); ++rep_) if (EN(2) && IN(pb + 0)) {
            PH_BEGIN();
            run_gemm_proj(F.lds, ws, args.in[(I_BIN) + zoff] + (size_t)l * NIN, l, G, bid, tid);
        }
        SEAM(pb + 0);

        for (int rep_ = 0; rep_ < REPS(3); ++rep_) if (EN(3) && IN(pb + 1)) {
            PH_BEGIN();
            if (!(args.pflags & 16)) phaseC_mlstm_all(F, ws, l);
            __syncthreads();
            if (!(args.pflags & 32)) { Frame Fu = F; asm volatile("" : "+v"(Fu.tid)); Fu.lane = Fu.tid & 63; phaseC_lru_all(Fu, ws, l); }
        }
        SEAM(pb + 1);

        for (int rep_ = 0; rep_ < REPS(4); ++rep_) if (EN(4) && IN(pb + 2)) {
            PH_BEGIN();
            const int NSCAN = (G >= 8) ? (G / 4) : 1;
            if (bid < NSCAN) { if (!(args.pflags & 512)) {
                LAS float* chs = (LAS float*)F.lds;
                LAS float* decT = chs + 2048;
                LAS float* scT = decT + 1024;
                for (int i = tid; i < 2048; i += 512) chs[i] = CHS[i];
                __syncthreads();
                LAS float* mArr = scT + 1024;
                if (tid < 8) { float m = 0.f;
#pragma unroll 8
                    for (int c = 0; c < NC; ++c) { const float bl = chs[(c * 8 + tid) * 2], a = chs[(c * 8 + tid) * 2 + 1]; mArr[tid * 128 + c] = m; m = fmaxf(bl + m, a); } }
                __syncthreads();
                for (int i = tid; i < 1024; i += 512) { const int h = i >> 7, c = i & 127; const float bl = chs[(c * 8 + h) * 2], a = chs[(c * 8 + h) * 2 + 1], m = mArr[i]; const float mn = fmaxf(bl + m, a);
                    decT[i] = __expf(bl + m - mn); scT[i] = __expf(a - mn); if (bid == 0) MST[c * 8 + h] = m; }
                __syncthreads();
                for (int slot = bid * 512 + tid; slot < 32768; slot += NSCAN * 512) {
                    const int h = slot >> 12, idx = (slot & 4095) * 4;
                    bf16* p = UC + (size_t)h * 16384 + idx;
                    float C0 = 0.f, C1 = 0.f, C2 = 0.f, C3 = 0.f;
#pragma unroll 1
                    for (int c0 = 0; c0 < NC; c0 += 16) {
                        u32x2 u[16];
#pragma unroll
                        for (int q = 0; q < 16; ++q) u[q] = *(const u32x2*)(p + (size_t)(c0 + q) * 131072);
#pragma unroll
                        for (int q = 0; q < 16; ++q) { const float dec = decT[h * 128 + c0 + q], sc = scT[h * 128 + c0 + q];
                            u32x2 o; o.x = pk2(C0, C1); o.y = pk2(C2, C3);
                            *(u32x2*)(p + (size_t)(c0 + q) * 131072) = o;
                            C0 = dec * C0 + sc * bflo(u[q].x); C1 = dec * C1 + sc * bfhi(u[q].x); C2 = dec * C2 + sc * bflo(u[q].y); C3 = dec * C3 + sc * bfhi(u[q].y); }
                    }
                }
                for (int id = bid * 512 + tid; id < 1024; id += NSCAN * 512) {
                    const int h = id >> 7, d = id & 127; float nn = 0.f;
#pragma unroll 1
                    for (int c0 = 0; c0 < NC; c0 += 16) {
                        float nl[16];
#pragma unroll
                        for (int q = 0; q < 16; ++q) nl[q] = NLOC[((c0 + q) * 8 + h) * 128 + d];
#pragma unroll
                        for (int q = 0; q < 16; ++q) { NST[((c0 + q) * 8 + h) * 128 + d] = nn; nn = decT[h * 128 + c0 + q] * nn + scT[h * 128 + c0 + q] * nl[q]; }
                    }
                }
            } } else {
                const int idx = bid - NSCAN, nw8 = (G - NSCAN) >> 3;
                if (idx < nw8 * 8 && !(args.pflags & 1024)) {
                    const int n = idx & 7, slot = idx >> 3;
                    LAS float* T = (LAS float*)F.lds;
                    LAS float* ptot = T + 16384;
                    {
                        const int d = tid & 127, part = tid >> 7; const int ch = n * 128 + d;
                        float A[32], Hh[32];
#pragma unroll
                        for (int q = 0; q < 32; ++q) { A[q] = AC[(part * 32 + q) * 1024 + ch]; Hh[q] = HC[(part * 32 + q) * 1024 + ch]; }
                        float P = 1.f, Hs = 0.f;
#pragma unroll
                        for (int q = 0; q < 32; ++q) { Hs = A[q] * Hs + Hh[q]; P *= A[q]; }
                        ptot[(part * 128 + d) * 2] = P; ptot[(part * 128 + d) * 2 + 1] = Hs;
                        __syncthreads();
                        float st = 0.f;
                        for (int pp = 0; pp < part; ++pp) st = ptot[(pp * 128 + d) * 2] * st + ptot[(pp * 128 + d) * 2 + 1];
#pragma unroll
                        for (int q = 0; q < 32; ++q) { T[(part * 32 + q) * 128 + d] = st; st = A[q] * st + Hh[q]; }
                    }
                    __syncthreads();
                    const int li = lane & 15, rsub = lane >> 4;
                    const float* gp = args.in[(I_LRUG) + zoff] + l * 1024 + n * 128 + 8 * li;
                    const f32x4 gn0 = *(const f32x4*)gp, gn1 = *(const f32x4*)(gp + 4);
                    for (int c = slot; c < NC; c += nw8) {
                        const f32x4 ca = *(const LAS f32x4*)(T + c * 128 + 8 * li), cb = *(const LAS f32x4*)(T + c * 128 + 8 * li + 4);
                        u32x4 hv[4], pv[4], gv[4];
#pragma unroll
                        for (int it = 0; it < 4; ++it) { const size_t gofs = ((size_t)c * CH + wave * 16 + it * 4 + rsub) * D + n * 128 + 8 * li;
                            hv[it] = *(const u32x4*)(HLOC + gofs); pv[it] = *(const u32x4*)(PCUM + gofs); gv[it] = *(const u32x4*)(GRb + gofs); }
#pragma unroll
                        for (int it = 0; it < 4; ++it) {
                            float y[8];
                            y[0] = (bflo(hv[it].x) + bflo(pv[it].x) * ca.x) * bflo(gv[it].x); y[1] = (bfhi(hv[it].x) + bfhi(pv[it].x) * ca.y) * bfhi(gv[it].x);
                            y[2] = (bflo(hv[it].y) + bflo(pv[it].y) * ca.z) * bflo(gv[it].y); y[3] = (bfhi(hv[it].y) + bfhi(pv[it].y) * ca.w) * bfhi(gv[it].y);
                            y[4] = (bflo(hv[it].z) + bflo(pv[it].z) * cb.x) * bflo(gv[it].z); y[5] = (bfhi(hv[it].z) + bfhi(pv[it].z) * cb.y) * bfhi(gv[it].z);
                            y[6] = (bflo(hv[it].w) + bflo(pv[it].w) * cb.z) * bflo(gv[it].w); y[7] = (bfhi(hv[it].w) + bfhi(pv[it].w) * cb.w) * bfhi(gv[it].w);
                            float ss = (y[0] * y[0] + y[1] * y[1]) + (y[2] * y[2] + y[3] * y[3]) + (y[4] * y[4] + y[5] * y[5]) + (y[6] * y[6] + y[7] * y[7]);
                            ss += __shfl_xor(ss, 1); ss += __shfl_xor(ss, 2); ss += __shfl_xor(ss, 4); ss += __shfl_xor(ss, 8);
                            const float rs = __builtin_amdgcn_rsqf(ss * (1.f / 128.f) + LN_EPS);
                            u32x4 o; o.x = pk2(y[0] * rs * gn0.x, y[1] * rs * gn0.y); o.y = pk2(y[2] * rs * gn0.z, y[3] * rs * gn0.w); o.z = pk2(y[4] * rs * gn1.x, y[5] * rs * gn1.y); o.w = pk2(y[6] * rs * gn1.z, y[7] * rs * gn1.w);
                            *(u32x4*)(Yb + ((size_t)c * CH + wave * 16 + it * 4 + rsub) * 2048 + 1024 + n * 128 + 8 * li) = o;
                        }
                    }
                }
            }
        }
        SEAM(pb + 2);

        for (int rep_ = 0; rep_ < REPS(5); ++rep_) if (EN(5) && IN(pb + 3)) {
            PH_BEGIN();
            for (int i = tid; i < 14 * 136 / 2; i += 512) ((LAS unsigned*)(F.lds + 69632 + 130 * 272))[i] = 0u;
            __syncthreads();
            phaseE_all(F, ws, l);
        }
        SEAM(pb + 3);

        for (int rep_ = 0; rep_ < REPS(6); ++rep_) if (EN(6) && IN(pb + 4)) {
            PH_BEGIN();
            run_gemm_out(F.lds, ws, l, G, bid, tid);
        }
        SEAM(pb + 4);

        for (int rep_ = 0; rep_ < REPS(7); ++rep_) if (EN(7) && IN(pb + 5)) {
            PH_BEGIN();
            constexpr int UP = 1032;
            LAS bf16* UH = (LAS bf16*)(F.lds); LAS bf16* UL = (LAS bf16*)(F.lds + 33024);
            LAS float* part = (LAS float*)(F.lds + 66048);
            LAS float* vecs = (LAS float*)(F.lds + 82432);
            LAS int* rinfo = (LAS int*)(F.lds + 102912);
            LAS int* lcnt = (LAS int*)(F.lds + 102912 + 4096);
            const int g = lane >> 4, li = lane & 15;
            bf16x8 bh[4][2], bl[4][2];
            {
                LAS float* wst = (LAS float*)F.lds;
                const f32x4* wsrc = (const f32x4*)args.in[(I_WR) + zoff];
#pragma unroll
                for (int it = 0; it < 16; ++it) *(LAS f32x4*)(wst + 4 * (tid + it * 512)) = wsrc[tid + it * 512];
                __syncthreads();
#pragma unroll
                for (int ks = 0; ks < 4; ++ks)
#pragma unroll
                    for (int nt = 0; nt < 2; ++nt)
#pragma unroll
                        for (int j = 0; j < 8; ++j) { const float wv = wst[(128 * wave + 32 * ks + 8 * g + j) * 32 + 16 * nt + li]; const unsigned hi = f2bf(wv);
                            bh[ks][nt][j] = (short)hi; bl[ks][nt][j] = (short)f2bf(wv - bf2f(hi)); }
                __syncthreads();
            }
            {
                const float* lng = args.in[(I_LNG) + zoff] + (size_t)(l * 2 + 0) * D; const float* lnb = args.in[(I_LNB) + zoff] + (size_t)(l * 2 + 0) * D;
                if (tid < 64) lcnt[tid] = 0;
                for (int i = tid; i < 1024; i += 512) { vecs[i] = ada[2048 + i]; vecs[1024 + i] = lng[i]; vecs[2048 + i] = lnb[i]; vecs[3072 + i] = 1.0f + ada[4096 + i]; vecs[4096 + i] = ada[3072 + i]; }
            }
            __syncthreads();
            const float* xin = args.in[(I_X) + zoff];
            f32x4 xp[2][4]; u32x2 xq[2][4], yp[2][4];
#define G_LOADROWS(GRP) do { _Pragma("unroll") for (int q = 0; q < 2; ++q) _Pragma("unroll") for (int j = 0; j < 4; ++j) { const size_t o = (size_t)((GRP) * 16 + 2 * wave + q) * D; \
        if constexpr (L == 0) xp[q][j] = *(const f32x4*)(xin + o + (256 * j + 4 * lane)); else xq[q][j] = *(const u32x2*)(XB + o + (256 * j + 4 * lane)); \
        yp[q][j] = *(const u32x2*)(YO + o + (256 * j + 4 * lane)); } } while (0)
            if (bid < S / 16) G_LOADROWS(bid);
#pragma unroll 1
            for (int grp = bid, gl = 0; grp < S / 16; grp += G, ++gl) {
                const int base = grp * 16;
                f32x4 v[2][4];
#pragma unroll
                for (int q = 0; q < 2; ++q)
#pragma unroll
                    for (int j = 0; j < 4; ++j) { f32x4 xv, yv; if constexpr (L == 0) xv = xp[q][j]; else { xv.x = bflo(xq[q][j].x); xv.y = bfhi(xq[q][j].x); xv.z = bflo(xq[q][j].y); xv.w = bfhi(xq[q][j].y); }
                        yv.x = bflo(yp[q][j].x); yv.y = bfhi(yp[q][j].x); yv.z = bflo(yp[q][j].y); yv.w = bfhi(yp[q][j].y);
                        v[q][j] = xv * ALPHA + *(const LAS f32x4*)(vecs + 256 * j + 4 * lane) * yv; }
                ln_row(v[0]); ln_row(v[1]);
#pragma unroll
                for (int q = 0; q < 2; ++q)
#pragma unroll
                    for (int j = 0; j < 4; ++j) { const int k = 256 * j + 4 * lane; v[q][j] = v[q][j] * *(const LAS f32x4*)(vecs + 1024 + k) + *(const LAS f32x4*)(vecs + 2048 + k);
                        u32x2 xw; xw.x = pk2(v[q][j].x, v[q][j].y); xw.y = pk2(v[q][j].z, v[q][j].w); *(u32x2*)(XB + (size_t)(base + 2 * wave + q) * D + (unsigned)k) = xw; }
                ln_row(v[0]); ln_row(v[1]);
#pragma unroll
                for (int q = 0; q < 2; ++q)
#pragma unroll
                    for (int j = 0; j < 4; ++j) { const int k = 256 * j + 4 * lane; const f32x4 u = v[q][j] * *(const LAS f32x4*)(vecs + 3072 + k) + *(const LAS f32x4*)(vecs + 4096 + k);
                        const unsigned h0 = f2bf(u.x), h1 = f2bf(u.y), h2 = f2bf(u.z), h3 = f2bf(u.w);
                        u32x2 wh; wh.x = h0 | (h1 << 16); wh.y = h2 | (h3 << 16);
                        u32x2 wl; wl.x = pk2(u.x - bf2f(h0), u.y - bf2f(h1)); wl.y = pk2(u.z - bf2f(h2), u.w - bf2f(h3));
                        *(u32x2*)(Ub + (size_t)(base + 2 * wave + q) * D + (unsigned)k) = wh;
                        *(LAS u32x2*)(UH + (2 * wave + q) * UP + k) = wh; *(LAS u32x2*)(UL + (2 * wave + q) * UP + k) = wl; }
                lds_barrier();
                if (grp + G < S / 16) G_LOADROWS(grp + G);
                if (!(args.pflags & 4)) {
                    f32x4 a0 = {0.f, 0.f, 0.f, 0.f}, a1 = {0.f, 0.f, 0.f, 0.f};
#pragma unroll
                    for (int ks = 0; ks < 4; ++ks) {
                        const bf16x8 ah = *(const LAS bf16x8*)(UH + li * UP + 128 * wave + 32 * ks + 8 * g), al = *(const LAS bf16x8*)(UL + li * UP + 128 * wave + 32 * ks + 8 * g);
                        a0 = mfma16(ah, bh[ks][0], a0); a0 = mfma16(ah, bl[ks][0], a0); a0 = mfma16(al, bh[ks][0], a0);
                        a1 = mfma16(ah, bh[ks][1], a1); a1 = mfma16(ah, bl[ks][1], a1); a1 = mfma16(al, bh[ks][1], a1);
                    }
#pragma unroll
                    for (int r = 0; r < 4; ++r) { part[(wave * 16 + 4 * g + r) * 32 + li] = a0[r]; part[(wave * 16 + 4 * g + r) * 32 + 16 + li] = a1[r]; }
                }
                lds_barrier();
                if (!(args.pflags & 2)) {
                    const int row = tid >> 5, e = tid & 31;
                    float logit = 0.f;
#pragma unroll
                    for (int w8 = 0; w8 < 8; ++w8) logit += part[(w8 * 16 + row) * 32 + e];
                    const float aff = sigmoid_f(logit); const float sel = aff + args.in[(I_BR) + zoff][e];
                    const int hb = lane & 32, gb = lane & ~3;
                    const float s0 = __shfl(sel, gb), s1 = __shfl(sel, gb + 1), s2 = __shfl(sel, gb + 2), s3 = __shfl(sel, gb + 3);
                    float t1 = s0; int i1 = 0; if (s1 > t1) { t1 = s1; i1 = 1; } if (s2 > t1) { t1 = s2; i1 = 2; } if (s3 > t1) { t1 = s3; i1 = 3; }
                    float t2 = -3.0e38f; if (i1 != 0) t2 = s0; if (i1 != 1 && s1 > t2) t2 = s1; if (i1 != 2 && s2 > t2) t2 = s2; if (i1 != 3 && s3 > t2) t2 = s3;
                    float gs = t1 + t2; int gi = e >> 2;
#pragma unroll
                    for (int o = 4; o < 32; o <<= 1) { const float og = __shfl_xor(gs, o); const int oi = __shfl_xor(gi, o); if (og > gs || (og == gs && oi < gi)) { gs = og; gi = oi; } }
                    const float b0 = __shfl(sel, hb + gi * 4), b1 = __shfl(sel, hb + gi * 4 + 1), b2 = __shfl(sel, hb + gi * 4 + 2), b3 = __shfl(sel, hb + gi * 4 + 3);
                    const float a0 = __shfl(aff, hb + gi * 4), a1 = __shfl(aff, hb + gi * 4 + 1), a2 = __shfl(aff, hb + gi * 4 + 2), a3 = __shfl(aff, hb + gi * 4 + 3);
                    float u1 = b0; int j1 = 0; if (b1 > u1) { u1 = b1; j1 = 1; } if (b2 > u1) { u1 = b2; j1 = 2; } if (b3 > u1) { u1 = b3; j1 = 3; }
                    float u2 = -3.0e38f; int j2 = 0;
                    if (j1 != 0) { u2 = b0; j2 = 0; }
                    if (j1 != 1 && b1 > u2) { u2 = b1; j2 = 1; }
                    if (j1 != 2 && b2 > u2) { u2 = b2; j2 = 2; }
                    if (j1 != 3 && b3 > u2) { u2 = b3; j2 = 3; }
                    const float af1 = (j1 == 0) ? a0 : (j1 == 1) ? a1 : (j1 == 2) ? a2 : a3;
                    const float af2 = (j2 == 0) ? a0 : (j2 == 1) ? a1 : (j2 == 2) ? a2 : a3;
                    const float inv = 1.f / (af1 + af2);
                    if (e == 0 && gl < 8) {
                        const int me0 = gi * 4 + j1, me1 = gi * 4 + j2; LAS int* ri = rinfo + (gl * 16 + row) * 8;
                        ri[0] = me0; ri[1] = me1; ri[2] = __hip_atomic_fetch_add(lcnt + me0, 1, __ATOMIC_RELAXED, __HIP_MEMORY_SCOPE_WORKGROUP); ri[3] = __hip_atomic_fetch_add(lcnt + me1, 1, __ATOMIC_RELAXED, __HIP_MEMORY_SCOPE_WORKGROUP);
                        ((LAS float*)ri)[4] = af1 * inv; ((LAS float*)ri)[5] = af2 * inv; ri[6] = base + row;
                    }
                }
            }
            lds_barrier();
            if (tid < 32 && !(args.pflags & 1)) lcnt[32 + tid] = (int)atomicAdd(ECNT + 64 * tid, (unsigned)lcnt[tid]);
            __syncthreads();
            if (tid < 128 && tid < 16 * ((S / 16 - bid + G - 1) / G) && !(args.pflags & 1)) {
                const LAS int* ri = rinfo + tid * 8; const int me0 = ri[0], me1 = ri[1], tok = ri[6];
                const int p0 = lcnt[32 + me0] + ri[2], p1 = lcnt[32 + me1] + ri[3];
                TLIST[me0 * 16384 + p0] = tok; TLIST[me1 * 16384 + p1] = tok;
                TOKE[tok * 2] = me0; TOKE[tok * 2 + 1] = me1; TOKP[tok * 2] = p0; TOKP[tok * 2 + 1] = p1; TOKG[tok * 2] = ((const LAS float*)ri)[4]; TOKG[tok * 2 + 1] = ((const LAS float*)ri)[5];
            }
        }
#undef G_LOADROWS
        SEAM(pb + 5);

        for (int rep_ = 0; rep_ < REPS(8); ++rep_) if (EN(8) && IN(pb + 6)) {
            PH_BEGIN();
            const int ntiles = build_tile_table(F, l);
            run_gemm_gu(F.lds, ws, (unsigned*)(ws + WS_CTL) + CW_TILE + l * 4096, ntiles, G, bid, tid);
        }

        for (int rep_ = 0; rep_ < REPS(9); ++rep_) if (EN(9) && IN(pb + 7)) {
            PH_BEGIN();
            const int ntiles = build_tile_table(F, l);
            run_gemm_dn(F.lds, ws, (unsigned*)(ws + WS_CTL) + CW_TILE + l * 4096, ntiles, G, bid, tid);
        }
        SEAM(pb + 7);

        for (int rep_ = 0; rep_ < REPS(10); ++rep_) if (EN(10) && IN(pb + 8)) {
            PH_BEGIN();
            (void)build_tile_table(F, l);
            const LAS int* tt = (const LAS int*)(F.lds + LDS_TT);
            if (l + 1 < DEPTH) {
                LAS float* scr = (LAS float*)(F.lds + wave * 16384);
                for (int it = gw; it < 24576; it += NGW) conv_moe_item(F, l + 1, it, scr);
                __syncthreads();
                load_wif(F, l + 1, (LAS float*)F.lds);
                __syncthreads();
            }
            LAS float* vecs = (LAS float*)(F.lds + 65536);
            {
                const float* lng = args.in[(I_LNG) + zoff] + (size_t)(l * 2 + 1) * D; const float* lnb = args.in[(I_LNB) + zoff] + (size_t)(l * 2 + 1) * D;
                for (int i = tid; i < 1024; i += 512) { vecs[i] = ada[5120 + i]; vecs[1024 + i] = lng[i]; vecs[2048 + i] = lnb[i];
                    if (l + 1 < DEPTH) { vecs[3072 + i] = ADA[(l + 1) * 6144 + i]; vecs[4096 + i] = 1.0f + ADA[(l + 1) * 6144 + 1024 + i]; } }
                __syncthreads();
            }
            for (int row = gw; row < S; row += NGW) {
                const int e0 = TOKE[row * 2], e1 = TOKE[row * 2 + 1], p0 = TOKP[row * 2], p1 = TOKP[row * 2 + 1]; const float g0 = TOKG[row * 2], g1 = TOKG[row * 2 + 1];
                const int j0 = p0 >> 8, j1 = p1 >> 8;
                const size_t r0 = (size_t)((j0 < tt[225 + e0]) ? tt[32 + e0] + j0 : tt[257 + e0]) * 256 + (p0 & 255), r1 = (size_t)((j1 < tt[225 + e1]) ? tt[32 + e1] + j1 : tt[257 + e1]) * 256 + (p1 & 255);
                f32x4 v[4];
#pragma unroll
                for (int j = 0; j < 4; ++j) { const int k = 256 * j + 4 * lane; const u32x2 ya = *(const u32x2*)(YB + r0 * D + k), yb = *(const u32x2*)(YB + r1 * D + k);
                    f32x4 y; y.x = g0 * bflo(ya.x) + g1 * bflo(yb.x); y.y = g0 * bfhi(ya.x) + g1 * bfhi(yb.x); y.z = g0 * bflo(ya.y) + g1 * bflo(yb.y); y.w = g0 * bfhi(ya.y) + g1 * bfhi(yb.y);
                    const u32x2 xr = *(const u32x2*)(XB + (size_t)row * D + k); f32x4 xv; xv.x = bflo(xr.x); xv.y = bfhi(xr.x); xv.z = bflo(xr.y); xv.w = bfhi(xr.y); const f32x4 g2 = *(const LAS f32x4*)(vecs + k);
                    v[j] = xv * ALPHA + g2 * y; }
                ln_row(v);
#pragma unroll
                for (int j = 0; j < 4; ++j) { const int k = 256 * j + 4 * lane; v[j] = v[j] * *(const LAS f32x4*)(vecs + 1024 + k) + *(const LAS f32x4*)(vecs + 2048 + k);
                    if constexpr (L + 1 < DEPTH) { u32x2 xw; xw.x = pk2(v[j].x, v[j].y); xw.y = pk2(v[j].z, v[j].w); *(u32x2*)(XB + (size_t)row * D + k) = xw; } else *(f32x4*)(args.out + (size_t)row * D + k) = v[j]; }
                if (l + 1 < DEPTH) {
                    ln_row(v);
                    emit_u(F, v, vecs + 3072, vecs + 4096, row, (const LAS float*)F.lds, args.in[(I_BIN) + zoff] + (size_t)(l + 1) * NIN + 4096);
                }
            }
        }
        SEAM(pb + 8);
}

__global__ void __launch_bounds__(512, 2) fwd(Args args) {
    extern __shared__ __attribute__((aligned(16))) unsigned char lds_raw[];
    Frame F;
    F.lds = (LAS unsigned char*)lds_raw;
    F.tid = threadIdx.x; F.lane = F.tid & 63; F.wave = __builtin_amdgcn_readfirstlane(F.tid >> 6);
    F.G = gridDim.x; F.bid = blockIdx.x;
    F.in = args.in; F.out = args.out; F.ws = args.ws; F.zoff = 0; F.pflags = args.pflags;
    const int tid0 = threadIdx.x;
    unsigned char* ws0 = args.ws;
    const int lo = args.ph_lo, hi = args.ph_hi;
    volatile LAS unsigned* MISC = (volatile LAS unsigned*)(F.lds + LDS_MISC);
    if (tid0 < 64) MISC[tid0] = 0u;
    __syncthreads();
    XcdBarrier bar; bar.bar = (unsigned*)(ws0 + WS_CTL) + CW_BAR; bar.x = 0; bar.st = MISC + 8;
    const bool multi = (hi - lo) > 1;
    if (multi) bar = xcd_barrier_post((unsigned*)(ws0 + WS_CTL) + CW_BAR, MISC + 8);
    for (int rep_ = 0; rep_ < REPS(0); ++rep_) if (EN(0) && IN(0)) {
        PH_BEGIN();
        unsigned* ada_cnt = (unsigned*)(ws + WS_CTL) + CW_ADA;
        {
            LAS float* red = (LAS float*)F.lds;
            const float* c = args.in[(I_C) + zoff];
            for (int g = bid; g < 256; g += G) {
                const int l = g >> 7, n0 = (g & 127) * 48, c4 = tid % 12, kq = tid / 12;
                if (kq < 42) {
                    const float* w = args.in[(I_WADA) + zoff] + (size_t)l * D * 6144 + n0 + c4 * 4;
                    f32x4 acc = {0.f, 0.f, 0.f, 0.f};
#pragma unroll 5
                    for (int k = kq; k < D; k += 42) { const float cv = silu_f(c[k]); const f32x4 wv = *(const f32x4*)(w + (size_t)k * 6144); acc += wv * cv; }
                    *(LAS f32x4*)(red + kq * 48 + c4 * 4) = acc;
                }
                __syncthreads();
                if (tid < 48) { float s = 0.f; for (int q = 0; q < 42; ++q) s += red[q * 48 + tid];
                    __hip_atomic_store(ADA + l * 6144 + n0 + tid, s + args.in[(I_BADA) + zoff][l * 6144 + n0 + tid], __ATOMIC_RELAXED, __HIP_MEMORY_SCOPE_AGENT);
                    asm volatile("s_waitcnt vmcnt(0)" ::: "memory");
                    if (tid == 0 && rep_ == 0) __hip_atomic_fetch_add(ada_cnt, 1u, __ATOMIC_RELAXED, __HIP_MEMORY_SCOPE_AGENT); }
                __syncthreads();
            }
        }
        LAS float* scr = (LAS float*)(F.lds + wave * 16384);
        for (int it = gw; it < 2 * 4224; it += NGW) conv_dense_item(F, it, scr);
        for (int it = gw; it < 24576; it += NGW) conv_moe_item(F, 0, it, scr);
        __syncthreads();
        if (tid == 0) { unsigned sp = 0; while (__hip_atomic_load(ada_cnt, __ATOMIC_RELAXED, __HIP_MEMORY_SCOPE_AGENT) < 256u) { __builtin_amdgcn_s_sleep(2); if (++sp > (1u << 22)) break; }
            __builtin_amdgcn_fence(__ATOMIC_ACQUIRE, "agent"); asm volatile("s_waitcnt vmcnt(0)" ::: "memory"); }
        __syncthreads();
        LAS float* Wif = (LAS float*)F.lds;
        load_wif(F, 0, Wif);
        LAS float* vecs = (LAS float*)(F.lds + 65536);
        for (int i = tid; i < 1024; i += 512) { vecs[i] = ADA[i]; vecs[1024 + i] = 1.0f + ADA[1024 + i]; }
        __syncthreads();
        const float* x = args.in[(I_X) + zoff];
        for (int row = gw; row < S; row += NGW) {
            f32x4 v[4];
#pragma unroll
            for (int j = 0; j < 4; ++j) v[j] = *(const f32x4*)(x + (size_t)row * D + 256 * j + 4 * lane);
            ln_row(v);
            emit_u(F, v, vecs, vecs + 1024, row, Wif, args.in[(I_BIN) + zoff] + 4096);
        }
    }
    SEAM(1);

    layer_phases<0>(args, F, bar, lo, hi);
    layer_phases<1>(args, F, bar, lo, hi);
#undef IN
#undef INS
#undef SEAM
}

#ifndef PROBE_PHASE
#define PROBE_PHASE -1
#endif
#ifndef PROBE_FLAGS
#define PROBE_FLAGS 0
#endif
#ifndef PROBE_SPAN
#define PROBE_SPAN 0
#endif
#ifndef N_LAUNCH_MODE
#define N_LAUNCH_MODE 1
#endif
extern "C" void kernel_launch(void* const* d_in, const int* in_sizes, int n_in, void* d_out, int out_size, void* d_ws, size_t ws_size, hipStream_t stream) {
    static int grid = 0;
    if (grid == 0) {
        if (n_in != 25 || out_size != S * D || ws_size < WS_END) { fprintf(stderr, "kernel_launch: unexpected shapes: n_in %d out %d ws %zu\n", n_in, out_size, ws_size); grid = -1; return; }
        int dev = 0, cus = 0;
        if (hipGetDevice(&dev) != hipSuccess || hipDeviceGetAttribute(&cus, hipDeviceAttributeMultiprocessorCount, dev) != hipSuccess) { grid = -1; return; }
        if (hipFuncSetAttribute((const void*)fwd, hipFuncAttributeMaxDynamicSharedMemorySize, LDS_BYTES) != hipSuccess) { fprintf(stderr, "kernel_launch: hipFuncSetAttribute failed\n"); grid = -1; return; }
        int per_cu = 0;
        if (hipOccupancyMaxActiveBlocksPerMultiprocessor(&per_cu, (const void*)fwd, 512, LDS_BYTES) != hipSuccess || per_cu < 1) fprintf(stderr, "kernel_launch: occupancy query says %d\n", per_cu);
        (void)hipGetLastError();
        grid = cus;
    }
    if (grid < 0) return;
    (void)hipMemsetAsync((char*)d_ws + WS_CTL, 0, CTL_BYTES, stream);
    Args a{};
    for (int i = 0; i < 25; ++i) a.in[i] = (const float*)d_in[i];
    a.out = (float*)d_out; a.ws = (unsigned char*)d_ws;
#if N_LAUNCH_MODE == 1
    a.ph_lo = 0; a.ph_hi = NPH;
    hipLaunchKernelGGL(fwd, dim3(grid), dim3(512), LDS_BYTES, stream, a);
#if PROBE_PHASE >= 0
    a.ph_lo = PROBE_PHASE; a.ph_hi = PROBE_PHASE + 1 + PROBE_SPAN; a.out = (float*)((unsigned char*)d_ws + WS_B); a.pflags = PROBE_FLAGS;
    (void)hipMemsetAsync((char*)d_ws + WS_CTL, 0, CTL_BYTES, stream);
    hipLaunchKernelGGL(fwd, dim3(grid), dim3(512), LDS_BYTES, stream, a);
#endif
#else
    for (int ph = 0; ph < NPH; ++ph) { a.ph_lo = ph; a.ph_hi = ph + 1; hipLaunchKernelGGL(fwd, dim3(grid), dim3(512), LDS_BYTES, stream, a); }
#endif
}
```

```cpp
#include <hip/hip_runtime.h>
#include <cstdio>
#include <cstdint>

#define GAS __attribute__((address_space(1)))
#define LAS __attribute__((address_space(3)))
typedef unsigned short bf16;
typedef float f32x4 __attribute__((ext_vector_type(4)));
typedef float f32x2 __attribute__((ext_vector_type(2)));
typedef short bf16x8 __attribute__((ext_vector_type(8)));
typedef unsigned u32x4 __attribute__((ext_vector_type(4)));
typedef unsigned u32x2 __attribute__((ext_vector_type(2)));

#ifndef TS_ENABLE
#define TS_ENABLE 0
#endif
#ifndef TS_SEL
#define TS_SEL 0
#endif
#ifndef TS_AMP
#define TS_AMP 10
#endif
constexpr int S = 16384, D = 1024, DEPTH = 2, NH = 8, DH = 128, CH = 128, NC = S / CH, NE = 32, DFF = 512;
constexpr int NIN = 6160, NPROJ = 6144;
constexpr float LN_EPS = 1e-5f;
constexpr float ALPHA = 1.41421356237f;
constexpr int NPH = 2 + 9 * DEPTH;

constexpr size_t MiB = 1u << 20;
constexpr size_t WS_CTL = 0, CTL_BYTES = 131072;
constexpr size_t WS_ADA = 1 * MiB;
constexpr size_t WS_IFG = 2 * MiB;
constexpr size_t WS_BCUM = 3 * MiB;
constexpr size_t WS_CHS = 3 * MiB + 512 * 1024;
constexpr size_t WS_MST = WS_CHS + 16384;
constexpr size_t WS_NLOC = 4 * MiB;
constexpr size_t WS_NST = 4 * MiB + 512 * 1024;
constexpr size_t WS_AC = 5 * MiB;
constexpr size_t WS_HC = 5 * MiB + 512 * 1024;
constexpr size_t WS_TOKE = 6 * MiB;
constexpr size_t WS_TOKP = 6 * MiB + 256 * 1024;
constexpr size_t WS_TOKG = 6 * MiB + 512 * 1024;
constexpr size_t WS_TLIST = 7 * MiB;
constexpr size_t WS_WIN = 10 * MiB;
constexpr size_t WS_WOUT = 34 * MiB;
constexpr size_t WS_WAX = 42 * MiB;
constexpr size_t WS_WGU = 44 * MiB;
constexpr size_t WS_WDN = 108 * MiB;
constexpr size_t WS_U = 140 * MiB;
constexpr size_t WS_A = 172 * MiB;
constexpr size_t WS_V = 236 * MiB;
constexpr size_t WS_O = 268 * MiB;
constexpr size_t WS_XR = 300 * MiB;
constexpr size_t WS_GR = 332 * MiB;
constexpr size_t WS_B = 364 * MiB;
constexpr size_t WS_UC = 428 * MiB;
constexpr size_t WS_HLOC = 460 * MiB;
constexpr size_t WS_PCUM = 492 * MiB;
constexpr size_t WS_XB = 524 * MiB;
constexpr size_t WS_END = 556 * MiB;
constexpr size_t WS_HID = WS_V;
constexpr size_t WS_YB = WS_V + 40 * MiB;
static_assert(WS_YB + (size_t)40960 * 1024 * 2 <= WS_B, "moe overlay");

constexpr int CW_BAR = 4096;
constexpr int CW_ADA = 2048;
constexpr int CW_TILE = 16384;
constexpr int CW_TS = 24576;
constexpr int CW_CNT = 8192;

constexpr int LDS_SCR = 143360;
constexpr int LDS_TT = 143360;
constexpr int LDS_MISC = 144896;
constexpr int LDS_BYTES = 147456;

__device__ __forceinline__ float bf2f(unsigned b) { return __uint_as_float(b << 16); }
__device__ __forceinline__ float bflo(unsigned w) { return __uint_as_float(w << 16); }
__device__ __forceinline__ float bfhi(unsigned w) { return __uint_as_float(w & 0xffff0000u); }
__device__ __forceinline__ unsigned f2bf(float f) { unsigned u = __float_as_uint(f); return (u + 0x7fffu + ((u >> 16) & 1u)) >> 16; }
typedef __bf16 bf16x2_t __attribute__((ext_vector_type(2)));
__device__ __forceinline__ unsigned pk2(float lo, float hi) { const f32x2 v = {lo, hi}; return __builtin_bit_cast(unsigned, __builtin_convertvector(v, bf16x2_t)); }
__device__ __forceinline__ float rbf(float f) { return bf2f(f2bf(f)); }
template <int CTRL> __device__ __forceinline__ float dpp_mov(float x) { return __builtin_bit_cast(float, __builtin_amdgcn_mov_dpp(__builtin_bit_cast(int, x), CTRL, 0xf, 0xf, true)); }
__device__ __forceinline__ float wave_sum(float v) {
    v += dpp_mov<0xB1>(v); v += dpp_mov<0x4E>(v); v += dpp_mov<0x141>(v); v += dpp_mov<0x128>(v);
    const auto s = __builtin_amdgcn_permlane16_swap(__float_as_uint(v), __float_as_uint(v), false, false); v = __uint_as_float(s[0]) + __uint_as_float(s[1]);
    const auto t = __builtin_amdgcn_permlane32_swap(__float_as_uint(v), __float_as_uint(v), false, false); return __uint_as_float(t[0]) + __uint_as_float(t[1]);
}
__device__ __forceinline__ float wave_max(float v) {
    v = fmaxf(v, dpp_mov<0xB1>(v)); v = fmaxf(v, dpp_mov<0x4E>(v)); v = fmaxf(v, dpp_mov<0x141>(v)); v = fmaxf(v, dpp_mov<0x128>(v));
    const auto s = __builtin_amdgcn_permlane16_swap(__float_as_uint(v), __float_as_uint(v), false, false); v = fmaxf(__uint_as_float(s[0]), __uint_as_float(s[1]));
    const auto t = __builtin_amdgcn_permlane32_swap(__float_as_uint(v), __float_as_uint(v), false, false); return fmaxf(__uint_as_float(t[0]), __uint_as_float(t[1]));
}
__device__ __forceinline__ float row16_sum(float v) { v += dpp_mov<0xB1>(v); v += dpp_mov<0x4E>(v); v += dpp_mov<0x141>(v); v += dpp_mov<0x128>(v); return v; }
__device__ __forceinline__ float xrow_sum(float v) {
    const auto s = __builtin_amdgcn_permlane16_swap(__float_as_uint(v), __float_as_uint(v), false, false); v = __uint_as_float(s[0]) + __uint_as_float(s[1]);
    const auto t = __builtin_amdgcn_permlane32_swap(__float_as_uint(v), __float_as_uint(v), false, false); return __uint_as_float(t[0]) + __uint_as_float(t[1]); }
__device__ __forceinline__ float reduce16_scatter(float (&v)[16], int lane) {
#pragma unroll
    for (int i = 0; i < 8; ++i) { const auto r = __builtin_amdgcn_permlane32_swap(__float_as_uint(v[i]), __float_as_uint(v[i + 8]), false, false); v[i] = __uint_as_float(r[0]) + __uint_as_float(r[1]); }
#pragma unroll
    for (int i = 0; i < 4; ++i) { const auto r = __builtin_amdgcn_permlane16_swap(__float_as_uint(v[i]), __float_as_uint(v[i + 4]), false, false); v[i] = __uint_as_float(r[0]) + __uint_as_float(r[1]); }
    const float t0 = row16_sum(v[0]), t1 = row16_sum(v[1]), t2 = row16_sum(v[2]), t3 = row16_sum(v[3]);
    const int li = lane & 3;
    return li == 0 ? t0 : li == 1 ? t1 : li == 2 ? t2 : t3;
}
template <int CTRL> __device__ __forceinline__ float dpp_upd(float old, float x) { return __builtin_bit_cast(float, __builtin_amdgcn_update_dpp(__builtin_bit_cast(int, old), __builtin_bit_cast(int, x), CTRL, 0xf, 0xf, false)); }
__device__ __forceinline__ float rdlane(float v, int l) { return __builtin_bit_cast(float, __builtin_amdgcn_readlane(__builtin_bit_cast(int, v), l)); }
__device__ __forceinline__ float wave_scan_sum(float v, int lane) {
    v += dpp_upd<0x111>(0.f, v); v += dpp_upd<0x112>(0.f, v); v += dpp_upd<0x114>(0.f, v); v += dpp_upd<0x118>(0.f, v);
    const float r0 = rdlane(v, 15), r1 = rdlane(v, 31), r2 = rdlane(v, 47); const int row = lane >> 4;
    return v + ((row >= 1 ? r0 : 0.f) + (row >= 2 ? r1 : 0.f) + (row >= 3 ? r2 : 0.f));
}
__device__ __forceinline__ float wave_scan_max(float v, int lane) {
    constexpr float NEG = -3.0e38f;
    v = fmaxf(v, dpp_upd<0x111>(NEG, v)); v = fmaxf(v, dpp_upd<0x112>(NEG, v)); v = fmaxf(v, dpp_upd<0x114>(NEG, v)); v = fmaxf(v, dpp_upd<0x118>(NEG, v));
    const float r0 = rdlane(v, 15), r1 = rdlane(v, 31), r2 = rdlane(v, 47); const int row = lane >> 4;
    return fmaxf(v, fmaxf(row >= 1 ? r0 : NEG, fmaxf(row >= 2 ? r1 : NEG, row >= 3 ? r2 : NEG)));
}
__device__ __forceinline__ float fast_exp(float x) { return __builtin_amdgcn_exp2f(x * 1.4426950408889634f); }
__device__ __forceinline__ float fast_rcp(float x) { return __builtin_amdgcn_rcpf(x); }
__device__ __forceinline__ float sigmoid_f(float x) { return fast_rcp(1.f + fast_exp(-x)); }
__device__ __forceinline__ float silu_f(float x) { return x * fast_rcp(1.f + fast_exp(-x)); }
__device__ __forceinline__ float gelu_tanh_f(float x) { const float u = 0.7978845608f * (x + 0.044715f * x * x * x); const float t = 1.f - 2.f * fast_rcp(1.f + fast_exp(2.f * u)); return 0.5f * x * (1.f + t); }
__device__ __forceinline__ float logsigmoid_f(float x) { return fminf(x, 0.f) - log1pf(__expf(-fabsf(x))); }
__device__ __forceinline__ float softplus_f(float x) { return fmaxf(x, 0.f) + log1pf(__expf(-fabsf(x))); }

__device__ __forceinline__ void st16_wt(void* p, u32x4 v) { asm volatile("global_store_dwordx4 %0, %1, off sc1\n\ts_nop 1" :: "v"(p), "v"(v) : "memory"); }
__device__ __forceinline__ void st16_wt(void* p, f32x4 v) { asm volatile("global_store_dwordx4 %0, %1, off sc1\n\ts_nop 1" :: "v"(p), "v"(v) : "memory"); }

__device__ __forceinline__ void lds_barrier() { asm volatile("s_waitcnt lgkmcnt(0)" ::: "memory"); __builtin_amdgcn_s_barrier(); asm volatile("" ::: "memory"); }

template <int N> __device__ __forceinline__ float reduce_scatter(float (&v)[N], int lane) {
    if constexpr (N == 32) {
#pragma unroll
        for (int i = 0; i < 16; ++i) { const bool up = (lane & 32) != 0; const float send = up ? v[i] : v[i + 16]; const float recv = __shfl_xor(send, 32); v[i] = (up ? v[i + 16] : v[i]) + recv; }
    }
    constexpr int M0 = (N == 32) ? 16 : 32;
    {
#pragma unroll
        for (int i = 0; i < 8; ++i) { const bool up = (lane & M0) != 0; const float send = up ? v[i] : v[i + 8]; const float recv = __shfl_xor(send, M0); v[i] = (up ? v[i + 8] : v[i]) + recv; }
#pragma unroll
        for (int i = 0; i < 4; ++i) { const bool up = (lane & (M0 >> 1)) != 0; const float send = up ? v[i] : v[i + 4]; const float recv = __shfl_xor(send, M0 >> 1); v[i] = (up ? v[i + 4] : v[i]) + recv; }
#pragma unroll
        for (int i = 0; i < 2; ++i) { const bool up = (lane & (M0 >> 2)) != 0; const float send = up ? v[i] : v[i + 2]; const float recv = __shfl_xor(send, M0 >> 2); v[i] = (up ? v[i + 2] : v[i]) + recv; }
        { const bool up = (lane & (M0 >> 3)) != 0; const float send = up ? v[0] : v[1]; const float recv = __shfl_xor(send, M0 >> 3); v[0] = (up ? v[1] : v[0]) + recv; }
    }
    float r = v[0];
#pragma unroll
    for (int m = (M0 >> 4); m >= 1; m >>= 1) r += __shfl_xor(r, m);
    return r;
}

#define XB_TMO      128
#define XB_XCNT(j)  (256  + 64 * (j))
#define XB_XSUB(j)  (1280 + 64 * (j))
#define XB_XGEN(j)  (2304 + 64 * (j))
#define XB_TOP      3328
#define XB_TOPGEN   3392
#define XCD_BAR_WORDS 3456
#define XB_SPIN_CAP (1u << 18)

__device__ __forceinline__ unsigned xb_ld(unsigned* p)              { return __hip_atomic_load(p, __ATOMIC_RELAXED, __HIP_MEMORY_SCOPE_AGENT); }
__device__ __forceinline__ unsigned xb_add(unsigned* p, unsigned v) { return __hip_atomic_fetch_add(p, v, __ATOMIC_RELAXED, __HIP_MEMORY_SCOPE_AGENT); }
__device__ __forceinline__ unsigned xb_xcc_id() { return (unsigned)__builtin_amdgcn_s_getreg((3 << 11) | 20) & 0xFu; }
#define XB_SPIN(cond, bar) do { unsigned _sp = 0; while (cond) { __builtin_amdgcn_s_sleep(1); \
    if ((++_sp & 255u) == 0u) { if (xb_ld(&(bar)[XB_TMO])) break; if (_sp > XB_SPIN_CAP) { atomicAdd(&(bar)[XB_TMO], 1u); break; } } } } while (0)

struct XcdBarrier { unsigned* bar; unsigned x; volatile LAS unsigned* st; };

__device__ __forceinline__ XcdBarrier xcd_barrier_post(unsigned* bar, volatile LAS unsigned* st) {
    XcdBarrier b; b.bar = bar; b.x = xb_xcc_id(); b.st = st;
    if (threadIdx.x == 0) (void)xb_add(&bar[XB_XCNT(b.x)], 1u);
    return b;
}
__device__ __forceinline__ void xcd_barrier_complete(unsigned* bar, unsigned x, unsigned& nloc, unsigned& nx) {
    const unsigned G = gridDim.x * gridDim.y * gridDim.z;
    unsigned sum, cnt, mine, sp = 0u;
    for (;;) {
        sum = 0u; cnt = 0u; mine = 0u;
#pragma unroll
        for (unsigned j = 0; j < 16; ++j) { const unsigned c = xb_ld(&bar[XB_XCNT(j)]); sum += c; cnt += (c > 0u) ? 1u : 0u; mine = (j == x) ? c : mine; }
        if (sum == G) break;
        __builtin_amdgcn_s_sleep(1);
        if ((++sp & 255u) == 0u) { if (xb_ld(&bar[XB_TMO])) break; if (sp > XB_SPIN_CAP) { atomicAdd(&bar[XB_TMO], 1u); break; } }
    }
    nloc = mine > 0u ? mine : 1u; nx = cnt > 0u ? cnt : 1u;
}
__device__ __attribute__((noinline)) void xcd_barrier_impl(unsigned* bbar, unsigned bx, volatile LAS unsigned* bst) {
    XcdBarrier b; b.bar = bbar; b.x = bx; b.st = bst;
    asm volatile("s_waitcnt vmcnt(0)" ::: "memory");
    __syncthreads();
    if (threadIdx.x == 0) {
        unsigned* bar = b.bar;
        __builtin_amdgcn_s_waitcnt(0);
        unsigned nloc = b.st[0], nx = b.st[1];
        if (nloc == 0u) { xcd_barrier_complete(bar, b.x, nloc, nx); b.st[0] = nloc; b.st[1] = nx; }
        const unsigned old = xb_add(&bar[XB_XSUB(b.x)], 1u);
        const unsigned gen = old / nloc;
        if (old + 1u == (gen + 1u) * nloc) {
            __builtin_amdgcn_fence(__ATOMIC_RELEASE, "agent");
            asm volatile("s_waitcnt vmcnt(0)" ::: "memory");
            const unsigned og = xb_add(&bar[XB_TOP], 1u);
            const unsigned tg = og / nx;
            if (og + 1u == (tg + 1u) * nx) xb_add(&bar[XB_TOPGEN], 1u);
            else XB_SPIN(xb_ld(&bar[XB_TOPGEN]) == tg, bar);
            __builtin_amdgcn_fence(__ATOMIC_ACQUIRE, "agent");
            xb_add(&bar[XB_XGEN(b.x)], 1u);
            asm volatile("s_waitcnt vmcnt(0)" ::: "memory");
        } else {
            XB_SPIN(xb_ld(&bar[XB_XGEN(b.x)]) == gen, bar);
            __builtin_amdgcn_fence(__ATOMIC_ACQUIRE, "agent");
            asm volatile("s_waitcnt vmcnt(0)" ::: "memory");
        }
    }
    __syncthreads();
}

namespace pg8 {
constexpr int BM = 256, BK = 64, HALF = 128, HTB = HALF * BK * 2, STAGE_BYTES = 8 * HTB, NXCD = 8, WGM = 8;
__host__ __device__ __forceinline__ int lds_byte(int r, int c) { const int st = (r >> 4) * 2 + (c >> 5), rr = r & 15, cc = c & 31, ob = rr * 64 + cc * 2; return st * 1024 + (ob ^ (((ob >> 9) & 1) << 5)); }
__host__ __device__ __forceinline__ void stage_rc(int b, int& R, int& C) { const int st = b / 1024, sb = b % 1024, swz = sb ^ (((sb >> 9) & 1) << 5); R = (st >> 1) * 16 + swz / 64; C = (st & 1) * 32 + (swz % 64) / 2; }
__host__ __device__ __forceinline__ int perm32(int rho) { const int n = rho >> 4, i = rho & 15; return 8 * (i >> 2) + 4 * n + (i & 3); }

struct Unit { int pm, pn, e, j, half; };

struct DenseOrder {
    static constexpr bool HOOKS = false;
    int nM, nN, nwg, G, c;
    __device__ __forceinline__ void init(int M, int N, int G_, int c_) { nM = M / BM; nN = N / BM; nwg = nM * nN; G = G_; c = c_; }
    __device__ __forceinline__ bool next(int i, Unit& u) const {
        const long L = (long)i * G + c; if (L >= nwg) return false;
        int wgid = (int)L; { const int q = nwg / NXCD, r = nwg % NXCD, xcd = wgid % NXCD, off = wgid / NXCD; wgid = (xcd < r ? xcd * (q + 1) : r * (q + 1) + (xcd - r) * q) + off; }
        const int nig = WGM * nN, gid = wgid / nig, fm = gid * WGM, gsz = (nM - fm) < WGM ? (nM - fm) : WGM;
        u.pm = fm + ((wgid % nig) % gsz); u.pn = (wgid % nig) / gsz; u.e = 0; u.j = 0; u.half = 0; return true;
    }
    __device__ __forceinline__ size_t a_base(const Unit& u, int K) const { return (size_t)u.pm * 256 * K * 2; }
    __device__ __forceinline__ size_t b_base(const Unit& u, int K) const { return (size_t)u.pn * 256 * K * 2; }
    __device__ __forceinline__ void a_offs(const Unit&, int, const int (&)[2], const int (&)[2], unsigned (&)[4]) const {}
    __device__ __forceinline__ void a_ready(const Unit&, int) const {}
    __device__ __forceinline__ void done(int, int) const {}
};
struct MoeOrder {
    static constexpr bool HOOKS = true;
    const LAS int* tt;
    const int* tlist;
    int ntiles, G, c; size_t estrideB;
    __device__ __forceinline__ bool next(int i, Unit& u) const {
        const int L = i * G + c; if (L >= ntiles * 4) return false;
        const int tau = L >> 2; u.pn = L & 3; u.pm = tau; const int t = tt[65 + tau]; u.e = t >> 16; u.j = t & 0x7fff; u.half = (t >> 15) & 1; return true;
    }
    __device__ __forceinline__ size_t a_base(const Unit& u, int K) const { return (size_t)u.pm * 256 * K * 2; }
    __device__ __forceinline__ size_t b_base(const Unit& u, int K) const { return (size_t)u.e * estrideB + (size_t)u.pn * 256 * K * 2; }
    __device__ __forceinline__ void a_offs(const Unit& u, int K, const int (&R)[2], const int (&C)[2], unsigned (&o)[4]) const {
        const int cnt = tt[u.e];
#pragma unroll
        for (int h = 0; h < 2; ++h)
#pragma unroll
            for (int i = 0; i < 2; ++i) { const int idx = u.j * 256 + h * 128 + R[i]; int tok = 0; if (idx < cnt) tok = tlist[u.e * 16384 + idx]; o[h * 2 + i] = (unsigned)(tok * K + C[i]) * 2u; }
    }
    unsigned* tcnt; int mode;
    __device__ __forceinline__ void done(int pm, int lane) const {
        if (mode == 1 && lane == 0) __hip_atomic_fetch_add(tcnt + 16 * pm, 1u, __ATOMIC_RELAXED, __HIP_MEMORY_SCOPE_AGENT);
    }
    __device__ __forceinline__ void a_ready(const Unit& u, int wid) const {
        if (mode != 2) return;
        if (wid == 0) {
            unsigned sp = 0;
            while ((unsigned)__builtin_amdgcn_readfirstlane(__hip_atomic_load(tcnt + 16 * u.pm, __ATOMIC_RELAXED, __HIP_MEMORY_SCOPE_AGENT)) < 32u) { __builtin_amdgcn_s_sleep(2); if (++sp > (1u << 21)) break; }
            __builtin_amdgcn_fence(__ATOMIC_ACQUIRE, "agent");
            asm volatile("s_waitcnt vmcnt(0)" ::: "memory");
        }
        asm volatile("" ::: "memory"); __builtin_amdgcn_s_barrier(); asm volatile("" ::: "memory");
    }
};

__device__ __forceinline__ unsigned cvt_pk_bf16(float lo, float hi) { return pk2(lo, hi); }

struct EpiF32 {
    static constexpr bool PERM = false;
    float* C; int ldc;
    __device__ __forceinline__ void operator()(const f32x4 (&acc)[2][2][4][2], const Unit& u, int wr, int wc, int fr, int fq) const {
        const int row0 = u.pm * BM + wr * 64 + fr, col0 = u.pn * BM + wc * 32 + 4 * fq;
#pragma unroll
        for (int ai = 0; ai < 2; ++ai)
#pragma unroll
            for (int m = 0; m < 4; ++m) { float* rowp = C + (size_t)(row0 + ai * HALF + m * 16) * ldc + col0;
#pragma unroll
                for (int bj = 0; bj < 2; ++bj)
#pragma unroll
                    for (int n = 0; n < 2; ++n) st16_wt(rowp + bj * HALF + n * 16, acc[ai][bj][m][n]); }
    }
};
struct EpiProj {
    static constexpr bool PERM = true;
    bf16 *QK, *V, *O, *XR, *GR; const float* bias;
    __device__ __forceinline__ void operator()(const f32x4 (&acc)[2][2][4][2], const Unit& u, int wr, int wc, int fr, int fq) const {
        const int pn = u.pn; bf16* base; int ldc, colt, bcol, act;
        if (pn < 8) { base = QK; ldc = 2048; colt = pn * 256; bcol = pn * 256; act = 0; }
        else if (pn < 12) { base = V; ldc = 1024; colt = (pn - 8) * 256; bcol = pn * 256; act = 0; }
        else if (pn < 16) { base = O; ldc = 1024; colt = (pn - 12) * 256; bcol = pn * 256; act = 1; }
        else if (pn < 20) { base = XR; ldc = 1024; colt = (pn - 16) * 256; bcol = pn * 256 + 16; act = 0; }
        else { base = GR; ldc = 1024; colt = (pn - 20) * 256; bcol = pn * 256 + 16; act = 2; }
        const int row0 = u.pm * BM + wr * 64 + fr, col0 = colt + wc * 32 + 8 * fq, bcol0 = bcol + wc * 32 + 8 * fq;
        f32x4 bv[2][2];
#pragma unroll
        for (int bj = 0; bj < 2; ++bj)
#pragma unroll
            for (int n = 0; n < 2; ++n) bv[bj][n] = *(const f32x4*)(bias + bcol0 + bj * HALF + 4 * n);
#pragma unroll
        for (int ai = 0; ai < 2; ++ai)
#pragma unroll
            for (int m = 0; m < 4; ++m) { bf16* rowp = base + (size_t)(row0 + ai * HALF + m * 16) * ldc + col0;
#pragma unroll
                for (int bj = 0; bj < 2; ++bj) { f32x4 v0 = acc[ai][bj][m][0] + bv[bj][0], v1 = acc[ai][bj][m][1] + bv[bj][1];
                    if (act == 1) {
#pragma unroll
                        for (int q = 0; q < 4; ++q) { v0[q] = sigmoid_f(v0[q]); v1[q] = sigmoid_f(v1[q]); } }
                    if (act == 2) {
#pragma unroll
                        for (int q = 0; q < 4; ++q) { v0[q] = gelu_tanh_f(v0[q]); v1[q] = gelu_tanh_f(v1[q]); } }
                    u32x4 w; w.x = cvt_pk_bf16(v0[0], v0[1]); w.y = cvt_pk_bf16(v0[2], v0[3]); w.z = cvt_pk_bf16(v1[0], v1[1]); w.w = cvt_pk_bf16(v1[2], v1[3]);
                    st16_wt(rowp + bj * HALF, w); } }
    }
};
struct EpiHid {
    static constexpr bool PERM = true;
    bf16* H;
    __device__ __forceinline__ void operator()(const f32x4 (&acc)[2][2][4][2], const Unit& u, int wr, int wc, int fr, int fq) const {
        const int row0 = u.pm * BM + wr * 64 + fr, col0 = u.pn * 128 + wc * 32 + 8 * fq;
#pragma unroll
        for (int ai = 0; ai < 2; ++ai) { if (ai == 1 && u.half) break;
#pragma unroll
            for (int m = 0; m < 4; ++m) { bf16* rowp = H + (size_t)(row0 + ai * HALF + m * 16) * DFF + col0;
                f32x4 v0, v1;
#pragma unroll
                for (int q = 0; q < 4; ++q) { v0[q] = silu_f(acc[ai][0][m][0][q]) * acc[ai][1][m][0][q]; v1[q] = silu_f(acc[ai][0][m][1][q]) * acc[ai][1][m][1][q]; }
                u32x4 w; w.x = cvt_pk_bf16(v0[0], v0[1]); w.y = cvt_pk_bf16(v0[2], v0[3]); w.z = cvt_pk_bf16(v1[0], v1[1]); w.w = cvt_pk_bf16(v1[2], v1[3]);
                st16_wt(rowp, w); } }
    }
};
struct EpiBf16 {
    static constexpr bool PERM = true;
    bf16* O; int ldc;
    __device__ __forceinline__ void operator()(const f32x4 (&acc)[2][2][4][2], const Unit& u, int wr, int wc, int fr, int fq) const {
        const int row0 = u.pm * BM + wr * 64 + fr, col0 = u.pn * BM + wc * 32 + 8 * fq;
#pragma unroll
        for (int ai = 0; ai < 2; ++ai) { if (ai == 1 && u.half) break;
#pragma unroll
            for (int m = 0; m < 4; ++m) { bf16* rowp = O + (size_t)(row0 + ai * HALF + m * 16) * ldc + col0;
#pragma unroll
                for (int bj = 0; bj < 2; ++bj) { const f32x4 v0 = acc[ai][bj][m][0], v1 = acc[ai][bj][m][1];
                    u32x4 w; w.x = cvt_pk_bf16(v0[0], v0[1]); w.y = cvt_pk_bf16(v0[2], v0[3]); w.z = cvt_pk_bf16(v1[0], v1[1]); w.w = cvt_pk_bf16(v1[2], v1[3]);
                    st16_wt(rowp + bj * HALF, w); } } }
    }
};

template <class Epi, class Sched, bool GATHER, bool ALIGN_EPI>
__device__ __forceinline__ void gemm_phase(LAS unsigned char* lds, const bf16* Aptr, const bf16* Bptr, const int K, const Sched& S, const Epi& E, const int tid) {
    const int wid = __builtin_amdgcn_readfirstlane(tid >> 6), lane = tid & 63, wr = wid >> 2, wc = wid & 3, fr = lane & 15, fq = lane >> 4;
    const int nt = K / BK;
    unsigned voffA[2], voffB[2]; int RA[2], CA[2];
#pragma unroll
    for (int i = 0; i < 2; ++i) { int R, C; stage_rc(tid * 16 + i * 8192, R, C); const int Rb = Epi::PERM ? ((R & ~31) + perm32(R & 31)) : R;
        voffA[i] = (unsigned)(R * K + C) * 2u; voffB[i] = (unsigned)(Rb * K + C) * 2u; RA[i] = R; CA[i] = C; }
    const size_t kstep = (size_t)(BK * 2);
    const size_t hstep = (size_t)HALF * K * 2;
    const unsigned ldsw = (unsigned)wid * 1024u;
    const int aoff = lds_byte(wr * 64 + fr, fq * 8), boff = lds_byte(wc * 32 + fr, fq * 8);
#define PG8_SA(b, h) (((b) * 2 + (h)) * HTB)
#define PG8_SB(b, h) ((4 + (b) * 2 + (h)) * HTB)
#define PG8_GLDS(src, dstoff) __builtin_amdgcn_global_load_lds((const unsigned*)(src), (LAS unsigned*)(lds + (dstoff)), 16, 0, 0)
#define PG8_STAGE_B(bufoff, gbase) do { _Pragma("unroll") for (int _i = 0; _i < 2; ++_i) PG8_GLDS((const char*)(gbase) + voffB[_i], (bufoff) + ldsw + _i * 8192); } while (0)
#define PG8_STAGE_A(bufoff, gbase, h, OFF) do { if constexpr (GATHER) { _Pragma("unroll") for (int _i = 0; _i < 2; ++_i) PG8_GLDS((const char*)(gbase) + OFF[(h) * 2 + _i], (bufoff) + ldsw + _i * 8192); } \
        else { _Pragma("unroll") for (int _i = 0; _i < 2; ++_i) PG8_GLDS((const char*)(gbase) + (h) * hstep + voffA[_i], (bufoff) + ldsw + _i * 8192); } } while (0)
#define PG8_LDA(dst, b, h) do { _Pragma("unroll") for (int m = 0; m < 4; ++m) _Pragma("unroll") for (int k = 0; k < 2; ++k) dst[m][k] = *(const LAS bf16x8*)(lds + PG8_SA(b, h) + aoff + m * 2048 + k * 1024); } while (0)
#define PG8_LDB(dst, b, h) do { _Pragma("unroll") for (int n = 0; n < 2; ++n) _Pragma("unroll") for (int k = 0; k < 2; ++k) dst[n][k] = *(const LAS bf16x8*)(lds + PG8_SB(b, h) + boff + n * 2048 + k * 1024); } while (0)
#define PG8_MMA(ai, bj, At, Bt) do { __builtin_amdgcn_s_setprio(1); _Pragma("unroll") for (int m = 0; m < 4; ++m) _Pragma("unroll") for (int n = 0; n < 2; ++n) _Pragma("unroll") for (int k = 0; k < 2; ++k) \
        acc[ai][bj][m][n] = __builtin_amdgcn_mfma_f32_16x16x32_bf16(Bt[n][k], At[m][k], acc[ai][bj][m][n], 0, 0, 0); __builtin_amdgcn_s_setprio(0); } while (0)
#define PG8_WAIT_V(n) asm volatile("s_waitcnt vmcnt(" #n ")" ::: "memory")
#define PG8_WAIT_L(n) asm volatile("s_waitcnt lgkmcnt(" #n ")" ::: "memory")
#define PG8_BAR __builtin_amdgcn_s_barrier()
#define PG8_SCHED __builtin_amdgcn_sched_barrier(0)
    Unit cur, nxt; int ui = 0;
    if (!S.next(0, cur)) return;
    f32x4 acc[2][2][4][2];
#pragma unroll
    for (int a = 0; a < 2; ++a)
#pragma unroll
        for (int b = 0; b < 2; ++b)
#pragma unroll
            for (int m = 0; m < 4; ++m)
#pragma unroll
                for (int n = 0; n < 2; ++n) acc[a][b][m][n] = (f32x4){0.f, 0.f, 0.f, 0.f};
    bf16x8 At[4][2], B0[2][2], B1[2][2];
    unsigned offA[4] = {0u, 0u, 0u, 0u}, noffA[4] = {0u, 0u, 0u, 0u};
    const char* cA = GATHER ? (const char*)Aptr : (const char*)Aptr + S.a_base(cur, K);
    const char* cB = (const char*)Bptr + S.b_base(cur, K);
    if constexpr (GATHER) S.a_offs(cur, K, RA, CA, offA);
    if constexpr (Sched::HOOKS) S.a_ready(cur, wid);
    int pend_pm = -1;
    PG8_STAGE_B(PG8_SB(0, 0), cB); PG8_STAGE_B(PG8_SB(0, 1), cB + hstep); PG8_STAGE_A(PG8_SA(0, 0), cA, 0, offA); PG8_STAGE_A(PG8_SA(0, 1), cA, 1, offA);
    if (wr == 1) PG8_BAR;
    PG8_WAIT_V(2); PG8_BAR;
    PG8_STAGE_B(PG8_SB(1, 0), cB + kstep); PG8_STAGE_A(PG8_SA(1, 0), cA + kstep, 0, offA); PG8_STAGE_B(PG8_SB(1, 1), cB + hstep + kstep);
    PG8_WAIT_V(6); PG8_BAR;
    for (;;) {
        const bool has_next = S.next(ui + 1, nxt);
        const char* nA = cA; const char* nB = cB;
        if (has_next) { nA = GATHER ? (const char*)Aptr : (const char*)Aptr + S.a_base(nxt, K); nB = (const char*)Bptr + S.b_base(nxt, K); }
        if constexpr (GATHER) { if (has_next) S.a_offs(nxt, K, RA, CA, noffA); else {
#pragma unroll
            for (int q = 0; q < 4; ++q) noffA[q] = offA[q]; } }
        for (int t = 0; t < nt; t += 2) {
            const bool last = (t == nt - 2);
            if (t == 2 && pend_pm >= 0) { S.done(pend_pm, lane); pend_pm = -1; }
            if (last && has_next) S.a_ready(nxt, wid);
            const char* a1 = cA + (size_t)(t + 1) * kstep;
            const char* a2 = last ? nA : cA + (size_t)(t + 2) * kstep; const char* b2 = last ? nB : cB + (size_t)(t + 2) * kstep;
            const char* a3 = a2 + kstep; const char* b3 = b2 + kstep;
            unsigned o2[4];
#pragma unroll
            for (int q = 0; q < 4; ++q) o2[q] = last ? noffA[q] : offA[q];
            PG8_LDB(B0, 0, 0); PG8_LDB(B1, 0, 1); PG8_SCHED; PG8_LDA(At, 0, 0); PG8_STAGE_A(PG8_SA(1, 1), a1, 1, offA);
            PG8_WAIT_V(8); PG8_WAIT_L(0); PG8_BAR; PG8_MMA(0, 0, At, B0); PG8_MMA(0, 1, At, B1); PG8_BAR; PG8_SCHED;
            PG8_LDA(At, 0, 1); PG8_STAGE_B(PG8_SB(0, 0), b2); PG8_STAGE_B(PG8_SB(0, 1), b2 + hstep); PG8_STAGE_A(PG8_SA(0, 0), a2, 0, o2);
            PG8_WAIT_V(8); PG8_WAIT_L(0); PG8_BAR; if (!(Sched::HOOKS && cur.half)) { PG8_MMA(1, 0, At, B0); PG8_MMA(1, 1, At, B1); } PG8_BAR; PG8_SCHED;
            PG8_LDB(B0, 1, 0); PG8_LDB(B1, 1, 1); PG8_SCHED; PG8_LDA(At, 1, 0); PG8_STAGE_A(PG8_SA(0, 1), a2, 1, o2);
            PG8_WAIT_V(8); PG8_WAIT_L(0); PG8_BAR; PG8_MMA(0, 0, At, B0); PG8_MMA(0, 1, At, B1); PG8_BAR; PG8_SCHED;
            PG8_LDA(At, 1, 1); PG8_STAGE_B(PG8_SB(1, 0), b3); PG8_STAGE_B(PG8_SB(1, 1), b3 + hstep); PG8_STAGE_A(PG8_SA(1, 0), a3, 0, o2);
            PG8_WAIT_V(8); PG8_WAIT_L(0); PG8_BAR; if (!(Sched::HOOKS && cur.half)) { PG8_MMA(1, 0, At, B0); PG8_MMA(1, 1, At, B1); } PG8_BAR; PG8_SCHED;
        }
        if constexpr (ALIGN_EPI) { if (wr == 0) PG8_BAR; }
        E(acc, cur, wr, wc, fr, fq);
        if constexpr (Sched::HOOKS) pend_pm = cur.pm;
        if (!has_next) break;
#pragma unroll
        for (int a = 0; a < 2; ++a)
#pragma unroll
            for (int b = 0; b < 2; ++b)
#pragma unroll
                for (int m = 0; m < 4; ++m)
#pragma unroll
                    for (int n = 0; n < 2; ++n) acc[a][b][m][n] = (f32x4){0.f, 0.f, 0.f, 0.f};
        cur = nxt; cA = nA; cB = nB; ++ui;
#pragma unroll
        for (int q = 0; q < 4; ++q) offA[q] = noffA[q];
        if constexpr (ALIGN_EPI) { if (wr == 1) PG8_BAR; }
    }
    PG8_WAIT_V(0);
    if constexpr (Sched::HOOKS) { if (pend_pm >= 0) S.done(pend_pm, lane); }
    if constexpr (!ALIGN_EPI) { if (wr == 0) PG8_BAR; }
    PG8_BAR;
#undef PG8_SA
#undef PG8_SB
#undef PG8_GLDS
#undef PG8_STAGE_A
#undef PG8_STAGE_B
#undef PG8_LDA
#undef PG8_LDB
#undef PG8_MMA
#undef PG8_WAIT_V
#undef PG8_WAIT_L
#undef PG8_BAR
#undef PG8_SCHED
}
}

struct Args { const float* in[25]; float* out; unsigned char* ws; int ph_lo, ph_hi, pflags, pad; };
enum { I_X = 0, I_C, I_WADA, I_BADA, I_WIN, I_BIN, I_WCM, I_BCM, I_MHG, I_WCR, I_BCR, I_WA, I_BA, I_WX, I_BX, I_LAM, I_LRUG, I_WOUT, I_WR, I_BR, I_WG, I_WU, I_WD, I_LNG, I_LNB };

struct Frame {
    LAS unsigned char* lds;
    int tid, lane, wave, G, bid, zoff, pflags;
    const float* const* in; float* out; unsigned char* ws;
};

__device__ __forceinline__ void transpose_item(const float* W, int ldn, bf16* WT, int ldk, int k0, int n0, int drow0, LAS float* scr, int lane) {
    float tv[32];
#pragma unroll
    for (int i = 0; i < 32; ++i) { const int kk = 2 * i + (lane >> 5); tv[i] = W[(size_t)(k0 + kk) * ldn + n0 + (lane & 31)]; }
#pragma unroll
    for (int i = 0; i < 32; ++i) { const int kk = 2 * i + (lane >> 5); scr[kk * 33 + (lane & 31)] = tv[i]; }
    asm volatile("s_waitcnt lgkmcnt(0)" ::: "memory");
    const int c = lane & 7;
#pragma unroll
    for (int j = 0; j < 4; ++j) { const int n = (lane >> 3) + 8 * j; const LAS float* s = scr + (8 * c) * 33 + n;
        u32x4 o; o.x = pk2(s[0 * 33], s[1 * 33]); o.y = pk2(s[2 * 33], s[3 * 33]); o.z = pk2(s[4 * 33], s[5 * 33]); o.w = pk2(s[6 * 33], s[7 * 33]);
        *(u32x4*)(WT + (size_t)(drow0 + n) * ldk + k0 + 8 * c) = o; }
    asm volatile("s_waitcnt lgkmcnt(0)" ::: "memory");
}
__device__ __forceinline__ void conv_dense_item(const Frame& F, int it, LAS float* scr) {
    const int l = it / 4224; int r = it % 4224;
    const float* w_in = F.in[(I_WIN) + F.zoff] + (size_t)l * D * NIN;
    bf16* WIN = (bf16*)(F.ws + WS_WIN) + (size_t)l * NPROJ * D;
    if (r < 2048) { const int kb = r / 128, nb = r % 128; transpose_item(w_in, NIN, WIN, D, kb * 64, nb * 32, nb * 32, scr, F.lane); return; }
    r -= 2048;
    if (r < 1024) { const int kb = r / 64, nb = r % 64; transpose_item(w_in + 4112, NIN, WIN, D, kb * 64, nb * 32, 4096 + nb * 32, scr, F.lane); return; }
    r -= 1024;
    if (r < 1024) { const int kb = r / 32, nb = r % 32; transpose_item(F.in[(I_WOUT) + F.zoff] + (size_t)l * 2048 * 1024, 1024, (bf16*)(F.ws + WS_WOUT) + (size_t)l * 1024 * 2048, 2048, kb * 64, nb * 32, nb * 32, scr, F.lane); return; }
    r -= 1024;
    { const int which = r / 64; r %= 64; const int kb = r / 4, nb = r % 4;
      transpose_item(F.in[(which ? I_WX : I_WA) + F.zoff] + (size_t)l * 8 * 128 * 128, 128, (bf16*)(F.ws + WS_WAX) + (size_t)(l * 2 + which) * 128 * 1024, 1024, kb * 64, nb * 32, nb * 32, scr, F.lane); }
}
__device__ __forceinline__ void conv_moe_item(const Frame& F, int l, int it, LAS float* scr) {
    const int e = it / 768; int r = it % 768;
    if (r < 512) { const int which = r / 256; r %= 256; const int kb = r / 16, nb = r % 16, n0 = nb * 32, drow = (n0 / 128) * 256 + which * 128 + (n0 % 128);
        transpose_item(F.in[(which ? I_WU : I_WG) + F.zoff] + (size_t)(l * NE + e) * D * DFF, DFF, (bf16*)(F.ws + WS_WGU) + (size_t)e * 1024 * 1024, 1024, kb * 64, n0, drow, scr, F.lane); return; }
    r -= 512;
    { const int kb = r / 32, nb = r % 32; transpose_item(F.in[(I_WD) + F.zoff] + (size_t)(l * NE + e) * DFF * D, D, (bf16*)(F.ws + WS_WDN) + (size_t)e * 1024 * 512, 512, kb * 64, nb * 32, nb * 32, scr, F.lane); }
}

__device__ __forceinline__ void ln_row(f32x4 (&v)[4]) {
    float s = 0.f;
#pragma unroll
    for (int j = 0; j < 4; ++j) s += (v[j].x + v[j].y) + (v[j].z + v[j].w);
    const float mean = wave_sum(s) * (1.f / D); float s2 = 0.f;
#pragma unroll
    for (int j = 0; j < 4; ++j) { v[j] = v[j] - mean; s2 += (v[j].x * v[j].x + v[j].y * v[j].y) + (v[j].z * v[j].z + v[j].w * v[j].w); }
    const float rstd = __builtin_amdgcn_rsqf(wave_sum(s2) * (1.f / D) + LN_EPS);
#pragma unroll
    for (int j = 0; j < 4; ++j) v[j] = v[j] * rstd;
}
__device__ __forceinline__ void emit_u(const Frame& F, f32x4 (&v)[4], const LAS float* sh, const LAS float* sc1p, int row, const LAS float* Wif, const float* bif) {
    bf16* U_ = (bf16*)(F.ws + WS_U); float* IFG_ = (float*)(F.ws + WS_IFG);
    const int lane = F.lane;
#pragma unroll
    for (int j = 0; j < 4; ++j) { const f32x4 a = *(const LAS f32x4*)(sc1p + 256 * j + 4 * lane), b = *(const LAS f32x4*)(sh + 256 * j + 4 * lane); v[j] = v[j] * a + b;
        u32x2 w; w.x = pk2(v[j].x, v[j].y); w.y = pk2(v[j].z, v[j].w); *(u32x2*)(U_ + (size_t)row * D + 256 * j + 4 * lane) = w; }
    float part[16];
#pragma unroll
    for (int q = 0; q < 16; ++q) { float p = 0.f;
#pragma unroll
        for (int j = 0; j < 4; ++j) { const f32x4 w = *(const LAS f32x4*)(Wif + q * 1024 + 256 * j + 4 * lane); p += (v[j].x * w.x + v[j].y * w.y) + (v[j].z * w.z + v[j].w * w.w); }
        part[q] = p; if (q & 1) asm volatile("" ::: "memory"); }
    const float tot = reduce16_scatter(part, lane);
    if ((lane & 15) < 4) { const int q = 8 * (lane >> 5) + 4 * ((lane >> 4) & 1) + (lane & 3); IFG_[(size_t)row * 16 + q] = tot + bif[q]; }
}
__device__ __forceinline__ void load_wif(const Frame& F, int l, LAS float* Wif) {
    const float* w_in = F.in[(I_WIN) + F.zoff] + (size_t)l * D * NIN + 4096;
    for (int i = F.tid; i < 16 * 1024; i += 512) { const int k = i >> 4, q = i & 15; Wif[q * 1024 + k] = w_in[(size_t)k * NIN + q]; }
}

__device__ __forceinline__ int build_tile_table(const Frame& F, int l) {
    LAS int* tt = (LAS int*)(F.lds + LDS_TT);
    const unsigned* cnt = (const unsigned*)(F.ws + WS_CTL) + CW_CNT + l * 2048;
    __syncthreads();
    if (F.tid < 32) tt[F.tid] = (int)cnt[64 * F.tid];
    __syncthreads();
    if (F.tid == 0) { int b = 0;
#pragma unroll 1
        for (int e = 0; e < 32; ++e) { tt[32 + e] = b; const int cnt_e = tt[e], n = (cnt_e + 255) >> 8; const int lastrows = cnt_e - ((n - 1) << 8);
            const int nbig = (n > 0 && lastrows <= 128) ? n - 1 : n; tt[225 + e] = nbig;
            for (int j = 0; j < nbig; ++j) tt[65 + b + j] = (e << 16) | j; b += nbig; }
#pragma unroll 1
        for (int e = 0; e < 32; ++e) { const int cnt_e = tt[e], n = (cnt_e + 255) >> 8; tt[257 + e] = b;
            if (n > tt[225 + e]) { tt[65 + b] = (e << 16) | (1 << 15) | (n - 1); b += 1; } }
        tt[64] = b; }
    __syncthreads();
    return tt[64];
}


#define Ub    ((bf16*)(ws + WS_U))
#define QKpre ((bf16*)(ws + WS_A))
#define Yb    ((bf16*)(ws + WS_A))
#define Vb    ((bf16*)(ws + WS_V))
#define Ob    ((bf16*)(ws + WS_O))
#define XRb   ((bf16*)(ws + WS_XR))
#define GRb   ((bf16*)(ws + WS_GR))
#define Qb    ((bf16*)(ws + WS_B))
#define Kb    ((bf16*)(ws + WS_B) + (size_t)S * D)
#define YO    ((bf16*)(ws + WS_B))
#define XB    ((bf16*)(ws + WS_XB))
#define UC    ((bf16*)(ws + WS_UC))
#define HLOC  ((bf16*)(ws + WS_HLOC))
#define PCUM  ((bf16*)(ws + WS_PCUM))
#define IFG   ((float*)(ws + WS_IFG))
#define BCUM  ((float*)(ws + WS_BCUM))
#define CHS   ((float*)(ws + WS_CHS))
#define MST   ((float*)(ws + WS_MST))
#define NLOC  ((float*)(ws + WS_NLOC))
#define NST   ((float*)(ws + WS_NST))
#define AC    ((float*)(ws + WS_AC))
#define HC    ((float*)(ws + WS_HC))
#define TOKE  ((int*)(ws + WS_TOKE))
#define TOKP  ((int*)(ws + WS_TOKP))
#define TOKG  ((float*)(ws + WS_TOKG))
#define TLIST ((int*)(ws + WS_TLIST))
#define HID   ((bf16*)(ws + WS_HID))
#define YB    ((bf16*)(ws + WS_YB))
#define ADA   ((float*)(ws + WS_ADA))
#define ada   (ADA + l * 6144)
#define ECNT  ((unsigned*)(ws + WS_CTL) + CW_CNT + l * 2048)
#define PH_BEGIN() int zoff; asm volatile("s_mov_b32 %0, 0" : "=s"(zoff)); unsigned char* ws = args.ws + zoff; F.zoff = zoff; F.ws = ws; \
    int tid = threadIdx.x; asm volatile("" : "+v"(tid)); const int lane = tid & 63; const int wave = __builtin_amdgcn_readfirstlane(tid >> 6); \
    int G = gridDim.x; asm volatile("" : "+s"(G)); int bid = blockIdx.x; asm volatile("" : "+s"(bid)); \
    F.tid = tid; F.lane = lane; F.wave = wave; F.G = G; F.bid = bid; const int gw = bid * 8 + wave, NGW = G * 8; (void)gw; (void)NGW; (void)lane

typedef short s16x4 __attribute__((ext_vector_type(4)));
__device__ __forceinline__ bf16x8 tr_read2(const LAS bf16* p0, const LAS bf16* p1) {
    const s16x4 a = __builtin_amdgcn_ds_read_tr16_b64_v4i16((LAS s16x4*)p0), b = __builtin_amdgcn_ds_read_tr16_b64_v4i16((LAS s16x4*)p1);
    bf16x8 r; r[0] = a[0]; r[1] = a[1]; r[2] = a[2]; r[3] = a[3]; r[4] = b[0]; r[5] = b[1]; r[6] = b[2]; r[7] = b[3]; return r;
}
__device__ __forceinline__ f32x4 mfma16(bf16x8 a, bf16x8 b, f32x4 c) { return __builtin_amdgcn_mfma_f32_16x16x32_bf16(a, b, c, 0, 0, 0); }

__device__ __forceinline__ void phaseC_mlstm(const Frame& F, unsigned char* ws, int l, int c, int h) {
    const int tid = F.tid, lane = F.lane, wave = F.wave, zoff = F.zoff;
    constexpr int KP = 136, VP = 152;
    LAS bf16* Ks = (LAS bf16*)(F.lds); LAS bf16* Vs = (LAS bf16*)(F.lds + 34816); LAS float* wgt = (LAS float*)(F.lds + 73728);
    if (wave == 0) {
        const int t0 = 2 * lane; const size_t s0 = (size_t)c * CH + t0;
        const float i0 = IFG[s0 * 16 + h], i1 = IFG[(s0 + 1) * 16 + h], f0 = IFG[s0 * 16 + 8 + h], f1 = IFG[(s0 + 1) * 16 + 8 + h];
        const float l0 = logsigmoid_f(f0), l1 = logsigmoid_f(f1);
        const float pair = l0 + l1; float incl = pair;
#pragma unroll
        for (int o = 1; o < 64; o <<= 1) { const float t = __shfl_up(incl, o); if (lane >= o) incl += t; }
        const float b0 = incl - pair + l0, b1 = incl;
        const float blast = __shfl(incl, 63);
        const float g0 = blast - b0 + i0, g1 = blast - b1 + i1;
        const float a = wave_max(fmaxf(g0, g1));
        wgt[t0] = __expf(g0 - a); wgt[t0 + 1] = __expf(g1 - a);
        BCUM[s0 * 8 + h] = b0; BCUM[(s0 + 1) * 8 + h] = b1;
        if (lane == 0) { CHS[(c * 8 + h) * 2] = blast; CHS[(c * 8 + h) * 2 + 1] = a; }
    }
    const int cg = tid & 15, rq = tid >> 4;
#pragma unroll 1
    for (int which = 0; which < 2; ++which) {
        const int col = which * 1024 + h * 128 + cg * 8;
        float w[4][8], bsv[8], xv[7][8];
        const float* wc_ = F.in[(I_WCM) + zoff] + (size_t)l * 4 * 2048 + col;
#pragma unroll
        for (int k = 0; k < 4; ++k) { const f32x4 a = *(const f32x4*)(wc_ + k * 2048), b = *(const f32x4*)(wc_ + k * 2048 + 4); w[k][0] = a.x; w[k][1] = a.y; w[k][2] = a.z; w[k][3] = a.w; w[k][4] = b.x; w[k][5] = b.y; w[k][6] = b.z; w[k][7] = b.w; }
        { const float* bp = F.in[(I_BCM) + zoff] + (size_t)l * 2048 + col; const f32x4 a = *(const f32x4*)bp, b = *(const f32x4*)(bp + 4); bsv[0] = a.x; bsv[1] = a.y; bsv[2] = a.z; bsv[3] = a.w; bsv[4] = b.x; bsv[5] = b.y; bsv[6] = b.z; bsv[7] = b.w; }
#pragma unroll
        for (int i = 0; i < 7; ++i) { const int s = c * CH + rq * 4 - 3 + i; u32x4 raw = {0u, 0u, 0u, 0u}; if (s >= 0) raw = *(const u32x4*)(QKpre + (size_t)s * 2048 + col);
            xv[i][0] = bflo(raw.x); xv[i][1] = bfhi(raw.x); xv[i][2] = bflo(raw.y); xv[i][3] = bfhi(raw.y); xv[i][4] = bflo(raw.z); xv[i][5] = bfhi(raw.z); xv[i][6] = bflo(raw.w); xv[i][7] = bfhi(raw.w); }
#pragma unroll
        for (int rr = 0; rr < 4; ++rr) { float y[8];
#pragma unroll
            for (int j = 0; j < 8; ++j) { float a = bsv[j];
#pragma unroll
                for (int k = 0; k < 4; ++k) a += w[k][j] * xv[rr + k][j];
                a = silu_f(a); if (which) a *= 0.08838834764831845f; y[j] = a; }
            u32x4 o; o.x = pk2(y[0], y[1]); o.y = pk2(y[2], y[3]); o.z = pk2(y[4], y[5]); o.w = pk2(y[6], y[7]);
            const size_t srow = (size_t)c * CH + rq * 4 + rr;
            *(u32x4*)((which ? Kb : Qb) + srow * D + h * 128 + cg * 8) = o;
            if (which) *(LAS u32x4*)(Ks + (rq * 4 + rr) * KP + cg * 8) = o;
        }
    }
    __syncthreads();
#pragma unroll
    for (int rr = 0; rr < 4; ++rr) { const int r = rq * 4 + rr; const u32x4 raw = *(const u32x4*)(Vb + ((size_t)c * CH + r) * D + h * 128 + cg * 8); const float wg = wgt[r];
        u32x4 o; o.x = pk2(bflo(raw.x) * wg, bfhi(raw.x) * wg); o.y = pk2(bflo(raw.y) * wg, bfhi(raw.y) * wg); o.z = pk2(bflo(raw.z) * wg, bfhi(raw.z) * wg); o.w = pk2(bflo(raw.w) * wg, bfhi(raw.w) * wg);
        *(LAS u32x4*)(Vs + r * VP + cg * 8) = o;
        if (cg == 0) { u32x4 e0 = {f2bf(wg), 0u, 0u, 0u}, e1 = {0u, 0u, 0u, 0u}; *(LAS u32x4*)(Vs + r * VP + 128) = e0; *(LAS u32x4*)(Vs + r * VP + 136) = e1; } }
    __syncthreads();
    {
        const int g = lane >> 4, li = lane & 15, rsub = li >> 2, csub = 4 * (li & 3);
        bf16x8 af[4];
#pragma unroll
        for (int ks = 0; ks < 4; ++ks) af[ks] = tr_read2(Ks + (32 * ks + 8 * g + rsub) * KP + 16 * wave + csub, Ks + (32 * ks + 8 * g + 4 + rsub) * KP + 16 * wave + csub);
#pragma unroll
        for (int et = 0; et < 9; ++et) {
            f32x4 acc = {0.f, 0.f, 0.f, 0.f};
#pragma unroll
            for (int ks = 0; ks < 4; ++ks) { const bf16x8 bfr = tr_read2(Vs + (32 * ks + 8 * g + rsub) * VP + 16 * et + csub, Vs + (32 * ks + 8 * g + 4 + rsub) * VP + 16 * et + csub); acc = mfma16(af[ks], bfr, acc); }
            if (et < 8) { u32x2 o; o.x = pk2(acc[0], acc[1]); o.y = pk2(acc[2], acc[3]); *(u32x2*)(UC + ((size_t)(c * 8 + h) * 128 + 16 * et + li) * 128 + 16 * wave + 4 * g) = o; }
            else if (li == 0) *(f32x4*)(NLOC + (c * 8 + h) * 128 + 16 * wave + 4 * g) = acc;
        }
    }
    __syncthreads();
}

__device__ __forceinline__ void phaseC_lru(const Frame& F, unsigned char* ws, int l, int c, int n) {
    const int tid = F.tid, lane = F.lane, wave = F.wave, zoff = F.zoff;
    constexpr int XP = 136;
    LAS bf16* Xc = (LAS bf16*)(F.lds); LAS bf16* Was = (LAS bf16*)(F.lds + 34816); LAS bf16* Wxs = (LAS bf16*)(F.lds + 69632); LAS float* ex = (LAS float*)(F.lds + 104448);
    LAS bf16* Hst = Was; LAS bf16* Pst = Wxs;
    {
        const int cg = tid & 15, rq = tid >> 4; const int col = n * 128 + cg * 8;
        float w[4][8], bsv[8], xv[7][8];
        const float* wc_ = F.in[(I_WCR) + zoff] + (size_t)l * 4 * 1024 + col;
#pragma unroll
        for (int k = 0; k < 4; ++k) { const f32x4 a = *(const f32x4*)(wc_ + k * 1024), b = *(const f32x4*)(wc_ + k * 1024 + 4); w[k][0] = a.x; w[k][1] = a.y; w[k][2] = a.z; w[k][3] = a.w; w[k][4] = b.x; w[k][5] = b.y; w[k][6] = b.z; w[k][7] = b.w; }
        { const float* bp = F.in[(I_BCR) + zoff] + (size_t)l * 1024 + col; const f32x4 a = *(const f32x4*)bp, b = *(const f32x4*)(bp + 4); bsv[0] = a.x; bsv[1] = a.y; bsv[2] = a.z; bsv[3] = a.w; bsv[4] = b.x; bsv[5] = b.y; bsv[6] = b.z; bsv[7] = b.w; }
#pragma unroll
        for (int i = 0; i < 7; ++i) { const int s = c * CH + rq * 4 - 3 + i; u32x4 raw = {0u, 0u, 0u, 0u}; if (s >= 0) raw = *(const u32x4*)(XRb + (size_t)s * D + col);
            xv[i][0] = bflo(raw.x); xv[i][1] = bfhi(raw.x); xv[i][2] = bflo(raw.y); xv[i][3] = bfhi(raw.y); xv[i][4] = bflo(raw.z); xv[i][5] = bfhi(raw.z); xv[i][6] = bflo(raw.w); xv[i][7] = bfhi(raw.w); }
#pragma unroll
        for (int rr = 0; rr < 4; ++rr) { float y[8];
#pragma unroll
            for (int j = 0; j < 8; ++j) { float a = bsv[j];
#pragma unroll
                for (int k = 0; k < 4; ++k) a += w[k][j] * xv[rr + k][j];
                y[j] = a; }
            u32x4 o; o.x = pk2(y[0], y[1]); o.y = pk2(y[2], y[3]); o.z = pk2(y[4], y[5]); o.w = pk2(y[6], y[7]);
            *(LAS u32x4*)(Xc + (rq * 4 + rr) * XP + cg * 8) = o; }
        const bf16* wax = (const bf16*)(ws + WS_WAX) + (size_t)(l * 2) * 128 * 1024 + n * 128;
#pragma unroll
        for (int it = 0; it < 4; ++it) { const int i = tid + it * 512, dout = i >> 4, c8 = i & 15;
            *(LAS u32x4*)(Was + dout * XP + c8 * 8) = *(const u32x4*)(wax + (size_t)dout * 1024 + c8 * 8);
            *(LAS u32x4*)(Wxs + dout * XP + c8 * 8) = *(const u32x4*)(wax + (size_t)128 * 1024 + (size_t)dout * 1024 + c8 * 8); }
    }
    __syncthreads();
    const int g = lane >> 4, li = lane & 15;
    f32x4 aP[8], aH[8];
    {
        bf16x8 af[4];
#pragma unroll
        for (int ks = 0; ks < 4; ++ks) af[ks] = *(const LAS bf16x8*)(Xc + (16 * wave + li) * XP + 32 * ks + 8 * g);
#pragma unroll
        for (int nt = 0; nt < 8; ++nt) {
            f32x4 a0 = {0.f, 0.f, 0.f, 0.f}, a1 = {0.f, 0.f, 0.f, 0.f};
#pragma unroll
            for (int ks = 0; ks < 4; ++ks) { a0 = mfma16(af[ks], *(const LAS bf16x8*)(Was + (16 * nt + li) * XP + 32 * ks + 8 * g), a0); a1 = mfma16(af[ks], *(const LAS bf16x8*)(Wxs + (16 * nt + li) * XP + 32 * ks + 8 * g), a1); }
            aP[nt] = a0; aH[nt] = a1;
        }
    }
    float gP[8], gH[8];
#pragma unroll
    for (int nt = 0; nt < 8; ++nt) {
        const int ch = n * 128 + 16 * nt + li;
        const float ba = F.in[(I_BA) + zoff][l * 1024 + ch], bx = F.in[(I_BX) + zoff][l * 1024 + ch];
        const float sp = softplus_f(-F.in[(I_LAM) + zoff][l * 1024 + ch]);
        float hh = 0.f, pp = 1.f;
#pragma unroll
        for (int r = 0; r < 4; ++r) {
            const float xcv = bf2f(Xc[(16 * wave + 4 * g + r) * XP + 16 * nt + li]);
            const float rgate = sigmoid_f(aP[nt][r] + ba), ig = sigmoid_f(aH[nt][r] + bx);
            const float la = -8.0f * rgate * sp; const float a = fast_exp(la);
            const float xin = __builtin_amdgcn_sqrtf(1.0f - a * a) * (ig * xcv);
            hh = a * hh + xin; pp = pp * a; aP[nt][r] = pp; aH[nt][r] = hh;
        }
        const float p0 = __shfl(pp, li), p1 = __shfl(pp, li + 16), p2 = __shfl(pp, li + 32), p3 = __shfl(pp, li + 48);
        const float h0 = __shfl(hh, li), h1 = __shfl(hh, li + 16), h2 = __shfl(hh, li + 32), h3 = __shfl(hh, li + 48);
        float cP = 1.f, cH = 0.f;
        if (g > 0) { cH = p0 * cH + h0; cP = cP * p0; }
        if (g > 1) { cH = p1 * cH + h1; cP = cP * p1; }
        if (g > 2) { cH = p2 * cH + h2; cP = cP * p2; }
        gP[nt] = cP; gH[nt] = cH;
        if (g == 0) { float wP = p0, wH = h0; wH = p1 * wH + h1; wP *= p1; wH = p2 * wH + h2; wP *= p2; wH = p3 * wH + h3; wP *= p3;
            ex[(wave * 128 + 16 * nt + li) * 2] = wP; ex[(wave * 128 + 16 * nt + li) * 2 + 1] = wH; }
    }
    __syncthreads();
#pragma unroll
    for (int nt = 0; nt < 8; ++nt) {
        float wP = 1.f, wH = 0.f;
        for (int ww = 0; ww < wave; ++ww) { const float P = ex[(ww * 128 + 16 * nt + li) * 2], Hh = ex[(ww * 128 + 16 * nt + li) * 2 + 1]; wH = P * wH + Hh; wP = wP * P; }
        const float cH = gP[nt] * wH + gH[nt], cP = gP[nt] * wP;
#pragma unroll
        for (int r = 0; r < 4; ++r) { const float hf = aH[nt][r] + aP[nt][r] * cH, pf = aP[nt][r] * cP; const int sl = 16 * wave + 4 * g + r;
            Hst[sl * XP + 16 * nt + li] = (bf16)f2bf(hf); Pst[sl * XP + 16 * nt + li] = (bf16)f2bf(pf);
            if (wave == 7 && g == 3 && r == 3) { AC[c * 1024 + n * 128 + 16 * nt + li] = pf; HC[c * 1024 + n * 128 + 16 * nt + li] = hf; } }
    }
    __syncthreads();
#pragma unroll
    for (int it = 0; it < 4; ++it) { const int i = tid + it * 512, row = i >> 4, c8 = i & 15; const size_t gofs = ((size_t)c * CH + row) * D + n * 128 + c8 * 8;
        *(u32x4*)(HLOC + gofs) = *(const LAS u32x4*)(Hst + row * XP + c8 * 8); *(u32x4*)(PCUM + gofs) = *(const LAS u32x4*)(Pst + row * XP + c8 * 8); }
    __syncthreads();
}

__device__ __forceinline__ void phaseE_all(const Frame& F, unsigned char* ws, const int l) {
    const int tid = F.tid, lane = F.lane, wave = F.wave, zoff = F.zoff, G = F.G, bid = F.bid;
    constexpr int EP = 136;
    LAS bf16* Ks = (LAS bf16*)(F.lds); LAS bf16* Vs = (LAS bf16*)(F.lds + 34816); LAS bf16* Cs = (LAS bf16*)(F.lds + 69632);
    LAS float* wsv = (LAS float*)(F.lds + 104992); LAS float* Mt = wsv + 128; LAS float* bt = wsv + 256;
    LAS float* cwq = (LAS float*)(F.lds + 106528);
    LAS bf16* Os = (LAS bf16*)(F.lds + 109312);
    u32x4 kt[4], vt[4], ct[4], ot[4]; float nstv = 0.f, sb0 = 0.f, sb1 = 0.f, si0 = 0.f, si1 = 0.f, smp = 0.f;
#define E_LOAD(UNIT) do { const int c_ = (UNIT) >> 3, h_ = (UNIT) & 7; \
        _Pragma("unroll") for (int it = 0; it < 4; ++it) { const int i = tid + it * 512, r = i >> 4, cg = i & 15; const size_t gofs = ((size_t)c_ * CH + r) * D + h_ * 128 + cg * 8; \
            kt[it] = *(const u32x4*)(Kb + gofs); vt[it] = *(const u32x4*)(Vb + gofs); ot[it] = *(const u32x4*)(Ob + gofs); ct[it] = *(const u32x4*)(UC + (size_t)(c_ * 8 + h_) * 16384 + (size_t)i * 8); } \
        if (tid < 128) nstv = NST[(c_ * 8 + h_) * 128 + tid]; \
        if (wave == 1) { const size_t s0_ = (size_t)c_ * CH + 2 * lane; sb0 = BCUM[s0_ * 8 + h_]; sb1 = BCUM[(s0_ + 1) * 8 + h_]; si0 = IFG[s0_ * 16 + h_]; si1 = IFG[(s0_ + 1) * 16 + h_]; smp = MST[c_ * 8 + h_]; } } while (0)
    int hcur = -1;
    int unit = bid;
    if (unit < NC * 8) E_LOAD(unit);
#pragma unroll 1
    for (; unit < NC * 8; unit += G) {
        const int c = unit >> 3, h = unit & 7;
        if (h != hcur) { lds_barrier();
            for (int i = tid; i < 640; i += 512) { const int k5 = i >> 7, col = i & 127; cwq[i] = (k5 < 4) ? F.in[(I_WCM) + zoff][(size_t)l * 4 * 2048 + k5 * 2048 + h * 128 + col] : F.in[(I_BCM) + zoff][(size_t)l * 2048 + h * 128 + col]; }
            hcur = h; }
        u32x4 qraw[4][4];
        {
            const int tq = 16 * wave + (lane & 15);
#pragma unroll
            for (int ks = 0; ks < 4; ++ks)
#pragma unroll
                for (int k = 0; k < 4; ++k) { const int srow = c * CH + tq - 3 + k; qraw[ks][k] = (u32x4){0u, 0u, 0u, 0u}; if (srow >= 0) qraw[ks][k] = *(const u32x4*)(QKpre + (size_t)srow * 2048 + h * 128 + 32 * ks + 8 * (lane >> 4)); }
        }
#pragma unroll
        for (int it = 0; it < 4; ++it) { const int i = tid + it * 512, r = i >> 4, cg = i & 15;
            *(LAS u32x4*)(Ks + r * EP + cg * 8) = kt[it]; *(LAS u32x4*)(Vs + r * EP + cg * 8) = vt[it]; *(LAS u32x4*)(Os + r * 128 + cg * 8) = ot[it];
            { const u32x4 cv = ct[it];
              const int pos = i * 2, L = pos & 63, wv = (pos >> 6) & 7, et = pos >> 9, gg = L >> 4, ll = L & 15;
              u32x2 c0; c0.x = cv.x; c0.y = cv.y; u32x2 c1; c1.x = cv.z; c1.y = cv.w;
              *(LAS u32x2*)(Cs + (16 * et + ll) * EP + 16 * wv + 4 * gg) = c0; *(LAS u32x2*)(Cs + (16 * et + ll + 1) * EP + 16 * wv + 4 * gg) = c1; } }
        if (tid < 128) { const unsigned hi = f2bf(nstv); Cs[128 * EP + tid] = (bf16)hi; Cs[129 * EP + tid] = (bf16)f2bf(nstv - bf2f(hi)); }
        float mprev_u = 0.f;
        if (wave == 1) {
            const int t0 = 2 * lane;
            const float w0 = si0 - sb0, w1 = si1 - sb1;
            const float pm = fmaxf(w0, w1); const float incl = wave_scan_max(pm, lane);
            float excl = __shfl_up(incl, 1); if (lane == 0) excl = -3.0e38f;
            wsv[t0] = w0; wsv[t0 + 1] = w1; bt[t0] = sb0; bt[t0 + 1] = sb1;
            Mt[t0] = fmaxf(fmaxf(excl, w0), smp); Mt[t0 + 1] = fmaxf(incl, smp);
            if (lane == 0) cwq[640] = smp;
        }
        (void)mprev_u;
        lds_barrier();
        if (unit + G < NC * 8) E_LOAD(unit + G);
        {
            const int g = lane >> 4, li = lane & 15, t = 16 * wave + li;
            bf16x8 qf[4];
    #pragma unroll
            for (int ks = 0; ks < 4; ++ks) {
                u32x4 raw[4];
    #pragma unroll
                for (int k = 0; k < 4; ++k) raw[k] = qraw[ks][k];
                float y[8];
                { const f32x4 b0 = *(const LAS f32x4*)(cwq + 4 * 128 + 32 * ks + 8 * g), b1 = *(const LAS f32x4*)(cwq + 4 * 128 + 32 * ks + 8 * g + 4);
                  y[0] = b0.x; y[1] = b0.y; y[2] = b0.z; y[3] = b0.w; y[4] = b1.x; y[5] = b1.y; y[6] = b1.z; y[7] = b1.w; }
    #pragma unroll
                for (int k = 0; k < 4; ++k) { const f32x4 w0 = *(const LAS f32x4*)(cwq + k * 128 + 32 * ks + 8 * g), w1 = *(const LAS f32x4*)(cwq + k * 128 + 32 * ks + 8 * g + 4);
                    y[0] += w0.x * bflo(raw[k].x); y[1] += w0.y * bfhi(raw[k].x); y[2] += w0.z * bflo(raw[k].y); y[3] += w0.w * bfhi(raw[k].y);
                    y[4] += w1.x * bflo(raw[k].z); y[5] += w1.y * bfhi(raw[k].z); y[6] += w1.z * bflo(raw[k].w); y[7] += w1.w * bfhi(raw[k].w); }
                u32x4 pq; pq.x = pk2(silu_f(y[0]), silu_f(y[1])); pq.y = pk2(silu_f(y[2]), silu_f(y[3])); pq.z = pk2(silu_f(y[4]), silu_f(y[5])); pq.w = pk2(silu_f(y[6]), silu_f(y[7]));
                qf[ks] = __builtin_bit_cast(bf16x8, pq);
            }
            const float Mtt = Mt[t]; float dsum = 0.f;
            unsigned pk[8][2];
    #pragma unroll
            for (int st = 0; st < 8; ++st) {
                pk[st][0] = 0u; pk[st][1] = 0u;
                if (st <= wave) {
                    f32x4 sa = {0.f, 0.f, 0.f, 0.f};
    #pragma unroll
                    for (int ks = 0; ks < 4; ++ks) sa = mfma16(*(const LAS bf16x8*)(Ks + (16 * st + li) * EP + 32 * ks + 8 * g), qf[ks], sa);
                    const f32x4 w4 = *(const LAS f32x4*)(wsv + 16 * st + 4 * g);
                    float v[4];
    #pragma unroll
                    for (int r = 0; r < 4; ++r) { const int s = 16 * st + 4 * g + r; v[r] = (s <= t) ? sa[r] * __expf(w4[r] - Mtt) : 0.f; dsum += v[r]; }
                    pk[st][0] = pk2(v[0], v[1]); pk[st][1] = pk2(v[2], v[3]);
                }
            }
            dsum = xrow_sum(dsum);
            f32x4 nacc[8];
    #pragma unroll
            for (int et = 0; et < 8; ++et) nacc[et] = (f32x4){0.f, 0.f, 0.f, 0.f};
            const int rsub = li >> 2, csub = 4 * (li & 3);
    #pragma unroll
            for (int kp = 0; kp < 4; ++kp) {
                if (2 * kp <= wave) {
                    u32x4 pw = {pk[2 * kp][0], pk[2 * kp][1], pk[2 * kp + 1][0], pk[2 * kp + 1][1]};
                    const bf16x8 pf = __builtin_bit_cast(bf16x8, pw);
    #pragma unroll
                    for (int et = 0; et < 8; ++et) { const bf16x8 vf = tr_read2(Vs + (32 * kp + 4 * g + rsub) * EP + 16 * et + csub, Vs + (32 * kp + 16 + 4 * g + rsub) * EP + 16 * et + csub); nacc[et] = mfma16(vf, pf, nacc[et]); }
                }
            }
            f32x4 iacc[9];
    #pragma unroll
            for (int et = 0; et < 9; ++et) { f32x4 a = {0.f, 0.f, 0.f, 0.f};
    #pragma unroll
                for (int ks = 0; ks < 4; ++ks) a = mfma16(*(const LAS bf16x8*)(Cs + (16 * et + li) * EP + 32 * ks + 8 * g), qf[ks], a);
                iacc[et] = a; }
            float dint = iacc[8][0] + iacc[8][1]; dint = __shfl(dint, li);
            const float winter = __expf(cwq[640] - Mtt);
            const float den = dsum + winter * dint;
            const float dn = fmaxf(fabsf(den), __expf(-(bt[t] + Mtt)));
            const float inv = 1.f / dn;
            float sm = 0.f;
    #pragma unroll
            for (int et = 0; et < 8; ++et) { nacc[et] = (nacc[et] + iacc[et] * winter) * inv; sm += (nacc[et][0] + nacc[et][1]) + (nacc[et][2] + nacc[et][3]); }
            sm = xrow_sum(sm);
            const float mean = sm * (1.f / 128.f); float s2 = 0.f;
    #pragma unroll
            for (int et = 0; et < 8; ++et) { nacc[et] = nacc[et] - mean; s2 += (nacc[et][0] * nacc[et][0] + nacc[et][1] * nacc[et][1]) + (nacc[et][2] * nacc[et][2] + nacc[et][3] * nacc[et][3]); }
            s2 = xrow_sum(s2);
            const float rstd = __builtin_amdgcn_rsqf(s2 * (1.f / 128.f) + LN_EPS);
            const float* mg = F.in[(I_MHG) + zoff] + l * 1024 + h * 128 + 4 * g;
#pragma unroll
            for (int et = 0; et < 8; ++et) { const u32x2 o2 = *(const LAS u32x2*)(Os + t * 128 + 16 * et + 4 * g); const f32x4 gm = *(const f32x4*)(mg + 16 * et);
                u32x2 w; w.x = pk2(nacc[et][0] * rstd * bflo(o2.x) * gm.x, nacc[et][1] * rstd * bfhi(o2.x) * gm.y); w.y = pk2(nacc[et][2] * rstd * bflo(o2.y) * gm.z, nacc[et][3] * rstd * bfhi(o2.y) * gm.w);
                *(LAS u32x2*)(Os + t * 128 + 16 * et + 4 * g) = w; }
            asm volatile("s_waitcnt lgkmcnt(0)" ::: "memory");
#pragma unroll
            for (int it = 0; it < 4; ++it) { const int idx = lane + 64 * it, row = 16 * wave + (idx >> 4), c16 = idx & 15;
                *(u32x4*)(Yb + ((size_t)c * CH + row) * 2048 + h * 128 + c16 * 8) = *(const LAS u32x4*)(Os + row * 128 + c16 * 8); }
        }
        lds_barrier();
    }
#undef E_LOAD
}

__device__ __forceinline__ void phaseC_mlstm_all(const Frame& F, unsigned char* ws, const int l) {
    const int tid = F.tid, lane = F.lane, wave = F.wave, zoff = F.zoff, G = F.G, bid = F.bid;
    constexpr int KP = 136, VP = 152;
    LAS bf16* Ks = (LAS bf16*)(F.lds); LAS bf16* Vs = (LAS bf16*)(F.lds + 34816); LAS float* wgt = (LAS float*)(F.lds + 73728);
    LAS float* cw = (LAS float*)(F.lds + 74240);
    const int cg = tid & 15, rq = tid >> 4;
    u32x4 rk_[7], rv_[4]; float gi0 = 0.f, gi1 = 0.f, gf0 = 0.f, gf1 = 0.f;
    int hcur = -1;
#define C_LOAD(UNIT) do { const int c_ = (UNIT) >> 3, h_ = (UNIT) & 7; \
        _Pragma("unroll") for (int i = 0; i < 7; ++i) { const int s_ = c_ * CH + rq * 4 - 3 + i; rk_[i] = (u32x4){0u, 0u, 0u, 0u}; \
            if (s_ >= 0) rk_[i] = *(const u32x4*)(QKpre + (size_t)s_ * 2048 + 1024 + h_ * 128 + cg * 8); } \
        _Pragma("unroll") for (int rr = 0; rr < 4; ++rr) rv_[rr] = *(const u32x4*)(Vb + ((size_t)c_ * CH + rq * 4 + rr) * D + h_ * 128 + cg * 8); \
        if (wave == 0) { const size_t s0_ = (size_t)c_ * CH + 2 * lane; gi0 = IFG[s0_ * 16 + h_]; gi1 = IFG[(s0_ + 1) * 16 + h_]; gf0 = IFG[s0_ * 16 + 8 + h_]; gf1 = IFG[(s0_ + 1) * 16 + 8 + h_]; } } while (0)
    int unit = bid;
    if (unit < NC * 8) C_LOAD(unit);
#pragma unroll 1
    for (; unit < NC * 8; unit += G) {
        const int c = unit >> 3, h = unit & 7;
        if (h != hcur) {
            lds_barrier();
            for (int i = tid; i < 640; i += 512) { const int k5 = i >> 7, col = i & 127;
                cw[i] = (k5 < 4) ? F.in[(I_WCM) + zoff][(size_t)l * 4 * 2048 + k5 * 2048 + 1024 + h * 128 + col] : F.in[(I_BCM) + zoff][(size_t)l * 2048 + 1024 + h * 128 + col]; }
            hcur = h; lds_barrier();
        }
        if (wave == 0) {
            const int t0 = 2 * lane; const size_t s0 = (size_t)c * CH + t0;
            const float l0 = logsigmoid_f(gf0), l1 = logsigmoid_f(gf1);
            const float pair = l0 + l1; const float incl = wave_scan_sum(pair, lane);
            const float b0 = incl - pair + l0, b1 = incl;
            const float blast = rdlane(incl, 63);
            const float g0 = blast - b0 + gi0, g1 = blast - b1 + gi1;
            const float a = wave_max(fmaxf(g0, g1));
            wgt[t0] = __expf(g0 - a); wgt[t0 + 1] = __expf(g1 - a);
            BCUM[s0 * 8 + h] = b0; BCUM[(s0 + 1) * 8 + h] = b1;
            if (lane == 0) { CHS[(c * 8 + h) * 2] = blast; CHS[(c * 8 + h) * 2 + 1] = a; }
        }
        {
            float w[5][8];
#pragma unroll
            for (int k = 0; k < 5; ++k) { const f32x4 a = *(const LAS f32x4*)(cw + k * 128 + cg * 8), b = *(const LAS f32x4*)(cw + k * 128 + cg * 8 + 4);
                w[k][0] = a.x; w[k][1] = a.y; w[k][2] = a.z; w[k][3] = a.w; w[k][4] = b.x; w[k][5] = b.y; w[k][6] = b.z; w[k][7] = b.w; }
            float xv[7][8];
#pragma unroll
            for (int i = 0; i < 7; ++i) { const u32x4 raw = rk_[i];
                xv[i][0] = bflo(raw.x); xv[i][1] = bfhi(raw.x); xv[i][2] = bflo(raw.y); xv[i][3] = bfhi(raw.y); xv[i][4] = bflo(raw.z); xv[i][5] = bfhi(raw.z); xv[i][6] = bflo(raw.w); xv[i][7] = bfhi(raw.w); }
#pragma unroll
            for (int rr = 0; rr < 4; ++rr) { float y[8];
#pragma unroll
                for (int j = 0; j < 8; ++j) { float a = w[4][j];
#pragma unroll
                    for (int k = 0; k < 4; ++k) a += w[k][j] * xv[rr + k][j];
                    y[j] = silu_f(a) * 0.08838834764831845f; }
                u32x4 o; o.x = pk2(y[0], y[1]); o.y = pk2(y[2], y[3]); o.z = pk2(y[4], y[5]); o.w = pk2(y[6], y[7]);
                const size_t srow = (size_t)c * CH + rq * 4 + rr;
                *(u32x4*)(Kb + srow * D + h * 128 + cg * 8) = o;
                *(LAS u32x4*)(Ks + (rq * 4 + rr) * KP + cg * 8) = o;
            }
        }
        u32x4 vcur[4];
#pragma unroll
        for (int rr = 0; rr < 4; ++rr) vcur[rr] = rv_[rr];
        lds_barrier();
        if (unit + G < NC * 8) C_LOAD(unit + G);
#pragma unroll
        for (int rr = 0; rr < 4; ++rr) { const int r = rq * 4 + rr; const u32x4 raw = vcur[rr]; const float wg = wgt[r];
            u32x4 o; o.x = pk2(bflo(raw.x) * wg, bfhi(raw.x) * wg); o.y = pk2(bflo(raw.y) * wg, bfhi(raw.y) * wg); o.z = pk2(bflo(raw.z) * wg, bfhi(raw.z) * wg); o.w = pk2(bflo(raw.w) * wg, bfhi(raw.w) * wg);
            *(LAS u32x4*)(Vs + r * VP + cg * 8) = o;
            if (cg == 0) { u32x4 e0 = {f2bf(wg), 0u, 0u, 0u}, e1 = {0u, 0u, 0u, 0u}; *(LAS u32x4*)(Vs + r * VP + 128) = e0; *(LAS u32x4*)(Vs + r * VP + 136) = e1; } }
        lds_barrier();
        {
            const int g = lane >> 4, li = lane & 15, rsub = li >> 2, csub = 4 * (li & 3);
            bf16x8 af[4];
#pragma unroll
            for (int ks = 0; ks < 4; ++ks) af[ks] = tr_read2(Ks + (32 * ks + 8 * g + rsub) * KP + 16 * wave + csub, Ks + (32 * ks + 8 * g + 4 + rsub) * KP + 16 * wave + csub);
#pragma unroll
            for (int et = 0; et < 9; ++et) {
                f32x4 acc = {0.f, 0.f, 0.f, 0.f};
#pragma unroll
                for (int ks = 0; ks < 4; ++ks) { const bf16x8 bfr = tr_read2(Vs + (32 * ks + 8 * g + rsub) * VP + 16 * et + csub, Vs + (32 * ks + 8 * g + 4 + rsub) * VP + 16 * et + csub); acc = mfma16(af[ks], bfr, acc); }
                if (et < 8) { u32x2 o; o.x = pk2(acc[0], acc[1]); o.y = pk2(acc[2], acc[3]); *(u32x2*)(UC + (size_t)(c * 8 + h) * 16384 + ((et * 8 + wave) * 64 + lane) * 4) = o; }
                else if (li == 0) *(f32x4*)(NLOC + (c * 8 + h) * 128 + 16 * wave + 4 * g) = acc;
            }
        }
        lds_barrier();
    }
#undef C_LOAD
}

__device__ __forceinline__ void bcast4(float x, float& t0, float& t1, float& t2, float& t3) {
    const unsigned u = __float_as_uint(x);
    const auto s = __builtin_amdgcn_permlane16_swap(u, u, false, false);
    const auto a = __builtin_amdgcn_permlane32_swap(s[0], s[0], false, false);
    const auto b = __builtin_amdgcn_permlane32_swap(s[1], s[1], false, false);
    t0 = __uint_as_float(a[0]); t2 = __uint_as_float(a[1]); t1 = __uint_as_float(b[0]); t3 = __uint_as_float(b[1]);
}

__device__ __forceinline__ void phaseC_lru_all(const Frame& F, unsigned char* ws, const int l) {
    const int tid = F.tid, lane = F.lane, wave = F.wave, zoff = F.zoff, G = F.G, bid = F.bid;
    constexpr int XP = 136;
    LAS bf16* Xc = (LAS bf16*)(F.lds); LAS bf16* Hst = (LAS bf16*)(F.lds + 34816); LAS bf16* Pst = (LAS bf16*)(F.lds + 69632); LAS float* cwr = (LAS float*)(F.lds + 104448);
    const int cg = tid & 15, rq = tid >> 4, g = lane >> 4, li = lane & 15;
    u32x4 rx_[7];
    bf16x8 wa[4], wx[4]; float ba = 0.f, bx = 0.f, sp = 0.f;
    int ncur = -1;
#define L_LOAD(UNIT) do { const int c_ = (UNIT) >> 3, n_ = (UNIT) & 7; \
        _Pragma("unroll") for (int i = 0; i < 7; ++i) { const int s_ = c_ * CH + rq * 4 - 3 + i; rx_[i] = (u32x4){0u, 0u, 0u, 0u}; if (s_ >= 0) rx_[i] = *(const u32x4*)(XRb + (size_t)s_ * D + n_ * 128 + cg * 8); } } while (0)
    int unit = bid;
    if (unit < NC * 8) L_LOAD(unit);
#pragma unroll 1
    for (; unit < NC * 8; unit += G) {
        const int c = unit >> 3, n = unit & 7;
        if (n != ncur) {
            lds_barrier();
            for (int i = tid; i < 640; i += 512) { const int k5 = i >> 7, col = i & 127; cwr[i] = (k5 < 4) ? F.in[(I_WCR) + zoff][(size_t)l * 4 * 1024 + k5 * 1024 + n * 128 + col] : F.in[(I_BCR) + zoff][(size_t)l * 1024 + n * 128 + col]; }
            const bf16* wax = (const bf16*)(ws + WS_WAX) + (size_t)(l * 2) * 128 * 1024 + (size_t)(16 * wave + li) * 1024 + n * 128 + 8 * g;
#pragma unroll
            for (int ks = 0; ks < 4; ++ks) { wa[ks] = *(const bf16x8*)(wax + 32 * ks); wx[ks] = *(const bf16x8*)(wax + (size_t)128 * 1024 + 32 * ks); }
            const int ch = n * 128 + 16 * wave + li;
            ba = F.in[(I_BA) + zoff][l * 1024 + ch]; bx = F.in[(I_BX) + zoff][l * 1024 + ch]; sp = softplus_f(-F.in[(I_LAM) + zoff][l * 1024 + ch]);
            ncur = n; lds_barrier();
        }
        {
            float w[5][8];
#pragma unroll
            for (int k = 0; k < 5; ++k) { const f32x4 a = *(const LAS f32x4*)(cwr + k * 128 + cg * 8), b = *(const LAS f32x4*)(cwr + k * 128 + cg * 8 + 4);
                w[k][0] = a.x; w[k][1] = a.y; w[k][2] = a.z; w[k][3] = a.w; w[k][4] = b.x; w[k][5] = b.y; w[k][6] = b.z; w[k][7] = b.w; }
            float xv[7][8];
#pragma unroll
            for (int i = 0; i < 7; ++i) { const u32x4 raw = rx_[i];
                xv[i][0] = bflo(raw.x); xv[i][1] = bfhi(raw.x); xv[i][2] = bflo(raw.y); xv[i][3] = bfhi(raw.y); xv[i][4] = bflo(raw.z); xv[i][5] = bfhi(raw.z); xv[i][6] = bflo(raw.w); xv[i][7] = bfhi(raw.w); }
#pragma unroll
            for (int rr = 0; rr < 4; ++rr) { float y[8];
#pragma unroll
                for (int j = 0; j < 8; ++j) { float a = w[4][j];
#pragma unroll
                    for (int k = 0; k < 4; ++k) a += w[k][j] * xv[rr + k][j];
                    y[j] = a; }
                u32x4 o; o.x = pk2(y[0], y[1]); o.y = pk2(y[2], y[3]); o.z = pk2(y[4], y[5]); o.w = pk2(y[6], y[7]);
                *(LAS u32x4*)(Xc + (rq * 4 + rr) * XP + cg * 8) = o; }
        }
        lds_barrier();
        if (unit + G < NC * 8) L_LOAD(unit + G);
        f32x4 aA[8], aX[8];
#pragma unroll
        for (int tile = 0; tile < 8; ++tile) {
            f32x4 a0 = {0.f, 0.f, 0.f, 0.f}, a1 = {0.f, 0.f, 0.f, 0.f};
#pragma unroll
            for (int ks = 0; ks < 4; ++ks) { const bf16x8 af = *(const LAS bf16x8*)(Xc + (16 * tile + li) * XP + 32 * ks + 8 * g); a0 = mfma16(af, wa[ks], a0); a1 = mfma16(af, wx[ks], a1); }
            aA[tile] = a0; aX[tile] = a1;
        }
        float cP = 1.f, cH = 0.f;
        if (!(F.pflags & 128)) {
#pragma unroll
        for (int tile = 0; tile < 8; ++tile) {
            float hh = 0.f, pp = 1.f; float Pl[4], Hl[4];
#pragma unroll
            for (int r = 0; r < 4; ++r) {
                const float xcv = bf2f(Xc[(16 * tile + 4 * g + r) * XP + 16 * wave + li]);
                const float rgate = sigmoid_f(aA[tile][r] + ba), ig = sigmoid_f(aX[tile][r] + bx);
                const float la = -8.0f * rgate * sp; const float a = fast_exp(la);
                const float xin = __builtin_amdgcn_sqrtf(1.0f - a * a) * (ig * xcv);
                hh = a * hh + xin; pp = pp * a; Pl[r] = pp; Hl[r] = hh;
            }
            float p0, p1, p2, p3, h0, h1, h2, h3;
            bcast4(pp, p0, p1, p2, p3); bcast4(hh, h0, h1, h2, h3);
            float eP = cP, eH = cH;
            if (g > 0) { eH = p0 * eH + h0; eP = eP * p0; }
            if (g > 1) { eH = p1 * eH + h1; eP = eP * p1; }
            if (g > 2) { eH = p2 * eH + h2; eP = eP * p2; }
            if (!(F.pflags & 64)) {
#pragma unroll
            for (int r = 0; r < 4; ++r) { const int sl = 16 * tile + 4 * g + r;
                Hst[sl * XP + 16 * wave + li] = (bf16)f2bf(Hl[r] + Pl[r] * eH); Pst[sl * XP + 16 * wave + li] = (bf16)f2bf(Pl[r] * eP); }
            }
            cH = p0 * cH + h0; cP = cP * p0; cH = p1 * cH + h1; cP = cP * p1; cH = p2 * cH + h2; cP = cP * p2; cH = p3 * cH + h3; cP = cP * p3;
        }
        }
        if (g == 0) { AC[c * 1024 + n * 128 + 16 * wave + li] = cP; HC[c * 1024 + n * 128 + 16 * wave + li] = cH; }
        lds_barrier();
        if (!(F.pflags & 64)) {
#pragma unroll
        for (int it = 0; it < 4; ++it) { const int i = tid + it * 512, row = i >> 4, c8 = i & 15; const size_t gofs = ((size_t)c * CH + row) * D + n * 128 + c8 * 8;
            *(u32x4*)(HLOC + gofs) = *(const LAS u32x4*)(Hst + row * XP + c8 * 8); *(u32x4*)(PCUM + gofs) = *(const LAS u32x4*)(Pst + row * XP + c8 * 8); }
        }
    }
    lds_barrier();
#undef L_LOAD
}

static __device__ __forceinline__ void run_gemm_proj(LAS unsigned char* lds, unsigned char* ws, const float* bias, int l, int G, int bid, int tid) {
    pg8::DenseOrder So; So.init(S, NPROJ, G, bid);
    pg8::EpiProj E{QKpre, Vb, Ob, XRb, GRb, bias};
    pg8::gemm_phase<pg8::EpiProj, pg8::DenseOrder, false, true>(lds, Ub, (const bf16*)(ws + WS_WIN) + (size_t)l * NPROJ * D, D, So, E, tid);
}
static __device__ __forceinline__ void run_gemm_out(LAS unsigned char* lds, unsigned char* ws, int l, int G, int bid, int tid) {
    pg8::DenseOrder So; So.init(S, D, G, bid);
    pg8::EpiBf16 E{YO, D};
    pg8::gemm_phase<pg8::EpiBf16, pg8::DenseOrder, false, false>(lds, Yb, (const bf16*)(ws + WS_WOUT) + (size_t)l * 1024 * 2048, 2048, So, E, tid);
}
static __device__ __forceinline__ void run_gemm_gu(LAS unsigned char* lds, unsigned char* ws, unsigned* tcnt, int ntiles, int G, int bid, int tid) {
    pg8::MoeOrder So; So.tt = (const LAS int*)(lds + LDS_TT); So.tlist = TLIST; So.ntiles = ntiles; So.G = G; So.c = bid; So.estrideB = (size_t)1024 * 1024 * 2; So.tcnt = tcnt; So.mode = 1;
    pg8::EpiHid E{HID};
    pg8::gemm_phase<pg8::EpiHid, pg8::MoeOrder, true, true>(lds, Ub, (const bf16*)(ws + WS_WGU), D, So, E, tid);
}
static __device__ __forceinline__ void run_gemm_dn(LAS unsigned char* lds, unsigned char* ws, unsigned* tcnt, int ntiles, int G, int bid, int tid) {
    pg8::MoeOrder So; So.tt = (const LAS int*)(lds + LDS_TT); So.tlist = TLIST; So.ntiles = ntiles; So.G = G; So.c = G - 1 - bid; So.estrideB = (size_t)1024 * 512 * 2; So.tcnt = tcnt; So.mode = 2;
    pg8::EpiBf16 E{YB, D};
    pg8::gemm_phase<pg8::EpiBf16, pg8::MoeOrder, false, true>(lds, HID, (const bf16*)(ws + WS_WDN), DFF, So, E, tid);
}
#ifndef PH_MASK
#define PH_MASK 0xFFF
#endif
#define EN(b) (((PH_MASK) >> (b)) & 1)
#ifndef REPEAT_MASK
#define REPEAT_MASK 0
#endif
#define REPS(b) (1 + (((REPEAT_MASK) >> (b)) & 1))
#define IN(k) (lo <= (k) && (k) < hi && !(args.pflags & 256))
#define INS(k) (lo <= (k) && (k) < hi)
#if TS_ENABLE
#define SEAM(k) do { if (INS(k) && INS((k) + 1)) { __syncthreads(); if (threadIdx.x == 0) { unsigned* ts_ = (unsigned*)(args.ws + WS_CTL) + CW_TS + 4 * (k); const unsigned t_ = (unsigned)__builtin_amdgcn_s_memrealtime(); \
        atomicMax(ts_ + 1, t_); atomicAdd((unsigned long long*)(ts_ + 2), (unsigned long long)t_); } \
        xcd_barrier_impl(bar.bar, bar.x, bar.st); if (blockIdx.x == 0 && threadIdx.x == 0) ((unsigned*)(args.ws + WS_CTL))[CW_TS + 4 * (k)] = (unsigned)__builtin_amdgcn_s_memrealtime(); } } while (0)
#else
#define SEAM(k) do { if (INS(k) && INS((k) + 1)) { xcd_barrier_impl(bar.bar, bar.x, bar.st); } } while (0)
#endif


template <int L> __device__ __forceinline__ void layer_phases(const Args& args, Frame& F, const XcdBarrier& bar, const int lo, const int hi) {
    constexpr int l = L;
        const int pb = 2 + 9 * l;

        for (int rep_ = 0; rep_ < REPS(2); ++rep_) if (EN(2) && IN(pb + 0)) {
            PH_BEGIN();
            run_gemm_proj(F.lds, ws, args.in[(I_BIN) + zoff] + (size_t)l * NIN, l, G, bid, tid);
        }
        SEAM(pb + 0);

        for (int rep_ = 0; rep_ < REPS(3); ++rep_) if (EN(3) && IN(pb + 1)) {
            PH_BEGIN();
            if (!(args.pflags & 16)) phaseC_mlstm_all(F, ws, l);
            __syncthreads();
            if (!(args.pflags & 32)) { Frame Fu = F; asm volatile("" : "+v"(Fu.tid)); Fu.lane = Fu.tid & 63; phaseC_lru_all(Fu, ws, l); }
        }
        SEAM(pb + 1);

        for (int rep_ = 0; rep_ < REPS(4); ++rep_) if (EN(4) && IN(pb + 2)) {
            PH_BEGIN();
            const int NSCAN = (G >= 8) ? (G / 4) : 1;
            if (bid < NSCAN) { if (!(args.pflags & 512)) {
                LAS float* chs = (LAS float*)F.lds;
                LAS float* decT = chs + 2048;
                LAS float* scT = decT + 1024;
                for (int i = tid; i < 2048; i += 512) chs[i] = CHS[i];
                __syncthreads();
                LAS float* mArr = scT + 1024;
                if (tid < 8) { float m = 0.f;
#pragma unroll 8
                    for (int c = 0; c < NC; ++c) { const float bl = chs[(c * 8 + tid) * 2], a = chs[(c * 8 + tid) * 2 + 1]; mArr[tid * 128 + c] = m; m = fmaxf(bl + m, a); } }
                __syncthreads();
                for (int i = tid; i < 1024; i += 512) { const int h = i >> 7, c = i & 127; const float bl = chs[(c * 8 + h) * 2], a = chs[(c * 8 + h) * 2 + 1], m = mArr[i]; const float mn = fmaxf(bl + m, a);
                    decT[i] = __expf(bl + m - mn); scT[i] = __expf(a - mn); if (bid == 0) MST[c * 8 + h] = m; }
                __syncthreads();
                for (int slot = bid * 512 + tid; slot < 32768; slot += NSCAN * 512) {
                    const int h = slot >> 12, idx = (slot & 4095) * 4;
                    bf16* p = UC + (size_t)h * 16384 + idx;
                    float C0 = 0.f, C1 = 0.f, C2 = 0.f, C3 = 0.f;
#pragma unroll 1
                    for (int c0 = 0; c0 < NC; c0 += 16) {
                        u32x2 u[16];
#pragma unroll
                        for (int q = 0; q < 16; ++q) u[q] = *(const u32x2*)(p + (size_t)(c0 + q) * 131072);
#pragma unroll
                        for (int q = 0; q < 16; ++q) { const float dec = decT[h * 128 + c0 + q], sc = scT[h * 128 + c0 + q];
                            u32x2 o; o.x = pk2(C0, C1); o.y = pk2(C2, C3);
                            *(u32x2*)(p + (size_t)(c0 + q) * 131072) = o;
                            C0 = dec * C0 + sc * bflo(u[q].x); C1 = dec * C1 + sc * bfhi(u[q].x); C2 = dec * C2 + sc * bflo(u[q].y); C3 = dec * C3 + sc * bfhi(u[q].y); }
                    }
                }
                for (int id = bid * 512 + tid; id < 1024; id += NSCAN * 512) {
                    const int h = id >> 7, d = id & 127; float nn = 0.f;
#pragma unroll 1
                    for (int c0 = 0; c0 < NC; c0 += 16) {
                        float nl[16];
#pragma unroll
                        for (int q = 0; q < 16; ++q) nl[q] = NLOC[((c0 + q) * 8 + h) * 128 + d];
#pragma unroll
                        for (int q = 0; q < 16; ++q) { NST[((c0 + q) * 8 + h) * 128 + d] = nn; nn = decT[h * 128 + c0 + q] * nn + scT[h * 128 + c0 + q] * nl[q]; }
                    }
                }
            } } else {
                const int idx = bid - NSCAN, nw8 = (G - NSCAN) >> 3;
                if (idx < nw8 * 8 && !(args.pflags & 1024)) {
                    const int n = idx & 7, slot = idx >> 3;
                    LAS float* T = (LAS float*)F.lds;
                    LAS float* ptot = T + 16384;
                    {
                        const int d = tid & 127, part = tid >> 7; const int ch = n * 128 + d;
                        float A[32], Hh[32];
#pragma unroll
                        for (int q = 0; q < 32; ++q) { A[q] = AC[(part * 32 + q) * 1024 + ch]; Hh[q] = HC[(part * 32 + q) * 1024 + ch]; }
                        float P = 1.f, Hs = 0.f;
#pragma unroll
                        for (int q = 0; q < 32; ++q) { Hs = A[q] * Hs + Hh[q]; P *= A[q]; }
                        ptot[(part * 128 + d) * 2] = P; ptot[(part * 128 + d) * 2 + 1] = Hs;
                        __syncthreads();
                        float st = 0.f;
                        for (int pp = 0; pp < part; ++pp) st = ptot[(pp * 128 + d) * 2] * st + ptot[(pp * 128 + d) * 2 + 1];
#pragma unroll
                        for (int q = 0; q < 32; ++q) { T[(part * 32 + q) * 128 + d] = st; st = A[q] * st + Hh[q]; }
                    }
                    __syncthreads();
                    const int li = lane & 15, rsub = lane >> 4;
                    const float* gp = args.in[(I_LRUG) + zoff] + l * 1024 + n * 128 + 8 * li;
                    const f32x4 gn0 = *(const f32x4*)gp, gn1 = *(const f32x4*)(gp + 4);
                    for (int c = slot; c < NC; c += nw8) {
                        const f32x4 ca = *(const LAS f32x4*)(T + c * 128 + 8 * li), cb = *(const LAS f32x4*)(T + c * 128 + 8 * li + 4);
                        u32x4 hv[4], pv[4], gv[4];
#pragma unroll
                        for (int it = 0; it < 4; ++it) { const size_t gofs = ((size_t)c * CH + wave * 16 + it * 4 + rsub) * D + n * 128 + 8 * li;
                            hv[it] = *(const u32x4*)(HLOC + gofs); pv[it] = *(const u32x4*)(PCUM + gofs); gv[it] = *(const u32x4*)(GRb + gofs); }
#pragma unroll
                        for (int it = 0; it < 4; ++it) {
                            float y[8];
                            y[0] = (bflo(hv[it].x) + bflo(pv[it].x) * ca.x) * bflo(gv[it].x); y[1] = (bfhi(hv[it].x) + bfhi(pv[it].x) * ca.y) * bfhi(gv[it].x);
                            y[2] = (bflo(hv[it].y) + bflo(pv[it].y) * ca.z) * bflo(gv[it].y); y[3] = (bfhi(hv[it].y) + bfhi(pv[it].y) * ca.w) * bfhi(gv[it].y);
                            y[4] = (bflo(hv[it].z) + bflo(pv[it].z) * cb.x) * bflo(gv[it].z); y[5] = (bfhi(hv[it].z) + bfhi(pv[it].z) * cb.y) * bfhi(gv[it].z);
                            y[6] = (bflo(hv[it].w) + bflo(pv[it].w) * cb.z) * bflo(gv[it].w); y[7] = (bfhi(hv[it].w) + bfhi(pv[it].w) * cb.w) * bfhi(gv[it].w);
                            float ss = (y[0] * y[0] + y[1] * y[1]) + (y[2] * y[2] + y[3] * y[3]) + (y[4] * y[4] + y[5] * y[5]) + (y[6] * y[6] + y[7] * y[7]);
                            ss = row16_sum(ss);
                            const float rs = __builtin_amdgcn_rsqf(ss * (1.f / 128.f) + LN_EPS);
                            u32x4 o; o.x = pk2(y[0] * rs * gn0.x, y[1] * rs * gn0.y); o.y = pk2(y[2] * rs * gn0.z, y[3] * rs * gn0.w); o.z = pk2(y[4] * rs * gn1.x, y[5] * rs * gn1.y); o.w = pk2(y[6] * rs * gn1.z, y[7] * rs * gn1.w);
                            *(u32x4*)(Yb + ((size_t)c * CH + wave * 16 + it * 4 + rsub) * 2048 + 1024 + n * 128 + 8 * li) = o;
                        }
                    }
                }
            }
        }
        SEAM(pb + 2);

        for (int rep_ = 0; rep_ < REPS(5); ++rep_) if (EN(5) && IN(pb + 3)) {
            PH_BEGIN();
            phaseE_all(F, ws, l);
        }
        SEAM(pb + 3);

        for (int rep_ = 0; rep_ < REPS(6); ++rep_) if (EN(6) && IN(pb + 4)) {
            PH_BEGIN();
            run_gemm_out(F.lds, ws, l, G, bid, tid);
        }
        SEAM(pb + 4);

        for (int rep_ = 0; rep_ < REPS(7); ++rep_) if (EN(7) && IN(pb + 5)) {
            PH_BEGIN();
            constexpr int UP = 1032;
            LAS bf16* UH = (LAS bf16*)(F.lds); LAS bf16* UL = (LAS bf16*)(F.lds + 33024);
            LAS float* part = (LAS float*)(F.lds + 66048);
            LAS float* vecs = (LAS float*)(F.lds + 82432);
            LAS int* rinfo = (LAS int*)(F.lds + 102912);
            LAS int* lcnt = (LAS int*)(F.lds + 102912 + 4096);
            const int g = lane >> 4, li = lane & 15;
            bf16x8 bh[4][2], bl[4][2];
            {
                LAS float* wst = (LAS float*)F.lds;
                const f32x4* wsrc = (const f32x4*)args.in[(I_WR) + zoff];
#pragma unroll
                for (int it = 0; it < 16; ++it) *(LAS f32x4*)(wst + 4 * (tid + it * 512)) = wsrc[tid + it * 512];
                __syncthreads();
#pragma unroll
                for (int ks = 0; ks < 4; ++ks)
#pragma unroll
                    for (int nt = 0; nt < 2; ++nt)
#pragma unroll
                        for (int j = 0; j < 8; ++j) { const float wv = wst[(128 * wave + 32 * ks + 8 * g + j) * 32 + 16 * nt + li]; const unsigned hi = f2bf(wv);
                            bh[ks][nt][j] = (short)hi; bl[ks][nt][j] = (short)f2bf(wv - bf2f(hi)); }
                __syncthreads();
            }
            {
                const float* lng = args.in[(I_LNG) + zoff] + (size_t)(l * 2 + 0) * D; const float* lnb = args.in[(I_LNB) + zoff] + (size_t)(l * 2 + 0) * D;
                if (tid < 64) lcnt[tid] = 0;
                for (int i = tid; i < 1024; i += 512) { vecs[i] = ada[2048 + i]; vecs[1024 + i] = lng[i]; vecs[2048 + i] = lnb[i]; vecs[3072 + i] = 1.0f + ada[4096 + i]; vecs[4096 + i] = ada[3072 + i]; }
            }
            __syncthreads();
            const float* xin = args.in[(I_X) + zoff];
            f32x4 xp[2][4]; u32x2 xq[2][4], yp[2][4];
#define G_LOADROWS(GRP) do { _Pragma("unroll") for (int q = 0; q < 2; ++q) _Pragma("unroll") for (int j = 0; j < 4; ++j) { const size_t o = (size_t)((GRP) * 16 + 2 * wave + q) * D; \
        if constexpr (L == 0) xp[q][j] = *(const f32x4*)(xin + o + (256 * j + 4 * lane)); else xq[q][j] = *(const u32x2*)(XB + o + (256 * j + 4 * lane)); \
        yp[q][j] = *(const u32x2*)(YO + o + (256 * j + 4 * lane)); } } while (0)
            if (bid < S / 16) G_LOADROWS(bid);
#pragma unroll 1
            for (int grp = bid, gl = 0; grp < S / 16; grp += G, ++gl) {
                const int base = grp * 16;
                f32x4 v[2][4];
#pragma unroll
                for (int q = 0; q < 2; ++q)
#pragma unroll
                    for (int j = 0; j < 4; ++j) { f32x4 xv, yv; if constexpr (L == 0) xv = xp[q][j]; else { xv.x = bflo(xq[q][j].x); xv.y = bfhi(xq[q][j].x); xv.z = bflo(xq[q][j].y); xv.w = bfhi(xq[q][j].y); }
                        yv.x = bflo(yp[q][j].x); yv.y = bfhi(yp[q][j].x); yv.z = bflo(yp[q][j].y); yv.w = bfhi(yp[q][j].y);
                        v[q][j] = xv * ALPHA + *(const LAS f32x4*)(vecs + 256 * j + 4 * lane) * yv; }
                ln_row(v[0]); ln_row(v[1]);
#pragma unroll
                for (int q = 0; q < 2; ++q)
#pragma unroll
                    for (int j = 0; j < 4; ++j) { const int k = 256 * j + 4 * lane; v[q][j] = v[q][j] * *(const LAS f32x4*)(vecs + 1024 + k) + *(const LAS f32x4*)(vecs + 2048 + k);
                        u32x2 xw; xw.x = pk2(v[q][j].x, v[q][j].y); xw.y = pk2(v[q][j].z, v[q][j].w); *(u32x2*)(XB + (size_t)(base + 2 * wave + q) * D + (unsigned)k) = xw; }
                ln_row(v[0]); ln_row(v[1]);
#pragma unroll
                for (int q = 0; q < 2; ++q)
#pragma unroll
                    for (int j = 0; j < 4; ++j) { const int k = 256 * j + 4 * lane; const f32x4 u = v[q][j] * *(const LAS f32x4*)(vecs + 3072 + k) + *(const LAS f32x4*)(vecs + 4096 + k);
                        const unsigned h0 = f2bf(u.x), h1 = f2bf(u.y), h2 = f2bf(u.z), h3 = f2bf(u.w);
                        u32x2 wh; wh.x = h0 | (h1 << 16); wh.y = h2 | (h3 << 16);
                        u32x2 wl; wl.x = pk2(u.x - bf2f(h0), u.y - bf2f(h1)); wl.y = pk2(u.z - bf2f(h2), u.w - bf2f(h3));
                        *(u32x2*)(Ub + (size_t)(base + 2 * wave + q) * D + (unsigned)k) = wh;
                        *(LAS u32x2*)(UH + (2 * wave + q) * UP + k) = wh; *(LAS u32x2*)(UL + (2 * wave + q) * UP + k) = wl; }
                lds_barrier();
                if (grp + G < S / 16) G_LOADROWS(grp + G);
                if (!(args.pflags & 4)) {
                    f32x4 a0 = {0.f, 0.f, 0.f, 0.f}, a1 = {0.f, 0.f, 0.f, 0.f};
#pragma unroll
                    for (int ks = 0; ks < 4; ++ks) {
                        const bf16x8 ah = *(const LAS bf16x8*)(UH + li * UP + 128 * wave + 32 * ks + 8 * g), al = *(const LAS bf16x8*)(UL + li * UP + 128 * wave + 32 * ks + 8 * g);
                        a0 = mfma16(ah, bh[ks][0], a0); a0 = mfma16(ah, bl[ks][0], a0); a0 = mfma16(al, bh[ks][0], a0);
                        a1 = mfma16(ah, bh[ks][1], a1); a1 = mfma16(ah, bl[ks][1], a1); a1 = mfma16(al, bh[ks][1], a1);
                    }
#pragma unroll
                    for (int r = 0; r < 4; ++r) { part[(wave * 16 + 4 * g + r) * 32 + li] = a0[r]; part[(wave * 16 + 4 * g + r) * 32 + 16 + li] = a1[r]; }
                }
                lds_barrier();
                if (!(args.pflags & 2)) {
                    const int row = tid >> 5, e = tid & 31;
                    float logit = 0.f;
#pragma unroll
                    for (int w8 = 0; w8 < 8; ++w8) logit += part[(w8 * 16 + row) * 32 + e];
                    const float aff = sigmoid_f(logit); const float sel = aff + args.in[(I_BR) + zoff][e];
                    const int hb = lane & 32, gb = lane & ~3;
                    const float s0 = __shfl(sel, gb), s1 = __shfl(sel, gb + 1), s2 = __shfl(sel, gb + 2), s3 = __shfl(sel, gb + 3);
                    float t1 = s0; int i1 = 0; if (s1 > t1) { t1 = s1; i1 = 1; } if (s2 > t1) { t1 = s2; i1 = 2; } if (s3 > t1) { t1 = s3; i1 = 3; }
                    float t2 = -3.0e38f; if (i1 != 0) t2 = s0; if (i1 != 1 && s1 > t2) t2 = s1; if (i1 != 2 && s2 > t2) t2 = s2; if (i1 != 3 && s3 > t2) t2 = s3;
                    float gs = t1 + t2; int gi = e >> 2;
#pragma unroll
                    for (int o = 4; o < 32; o <<= 1) { const float og = __shfl_xor(gs, o); const int oi = __shfl_xor(gi, o); if (og > gs || (og == gs && oi < gi)) { gs = og; gi = oi; } }
                    const float b0 = __shfl(sel, hb + gi * 4), b1 = __shfl(sel, hb + gi * 4 + 1), b2 = __shfl(sel, hb + gi * 4 + 2), b3 = __shfl(sel, hb + gi * 4 + 3);
                    const float a0 = __shfl(aff, hb + gi * 4), a1 = __shfl(aff, hb + gi * 4 + 1), a2 = __shfl(aff, hb + gi * 4 + 2), a3 = __shfl(aff, hb + gi * 4 + 3);
                    float u1 = b0; int j1 = 0; if (b1 > u1) { u1 = b1; j1 = 1; } if (b2 > u1) { u1 = b2; j1 = 2; } if (b3 > u1) { u1 = b3; j1 = 3; }
                    float u2 = -3.0e38f; int j2 = 0;
                    if (j1 != 0) { u2 = b0; j2 = 0; }
                    if (j1 != 1 && b1 > u2) { u2 = b1; j2 = 1; }
                    if (j1 != 2 && b2 > u2) { u2 = b2; j2 = 2; }
                    if (j1 != 3 && b3 > u2) { u2 = b3; j2 = 3; }
                    const float af1 = (j1 == 0) ? a0 : (j1 == 1) ? a1 : (j1 == 2) ? a2 : a3;
                    const float af2 = (j2 == 0) ? a0 : (j2 == 1) ? a1 : (j2 == 2) ? a2 : a3;
                    const float inv = 1.f / (af1 + af2);
                    if (e == 0 && gl < 8) {
                        const int me0 = gi * 4 + j1, me1 = gi * 4 + j2; LAS int* ri = rinfo + (gl * 16 + row) * 8;
                        ri[0] = me0; ri[1] = me1; ri[2] = __hip_atomic_fetch_add(lcnt + me0, 1, __ATOMIC_RELAXED, __HIP_MEMORY_SCOPE_WORKGROUP); ri[3] = __hip_atomic_fetch_add(lcnt + me1, 1, __ATOMIC_RELAXED, __HIP_MEMORY_SCOPE_WORKGROUP);
                        ((LAS float*)ri)[4] = af1 * inv; ((LAS float*)ri)[5] = af2 * inv; ri[6] = base + row;
                    }
                }
            }
            lds_barrier();
            if (tid < 32 && !(args.pflags & 1)) lcnt[32 + tid] = (int)atomicAdd(ECNT + 64 * tid, (unsigned)lcnt[tid]);
            __syncthreads();
            if (tid < 128 && tid < 16 * ((S / 16 - bid + G - 1) / G) && !(args.pflags & 1)) {
                const LAS int* ri = rinfo + tid * 8; const int me0 = ri[0], me1 = ri[1], tok = ri[6];
                const int p0 = lcnt[32 + me0] + ri[2], p1 = lcnt[32 + me1] + ri[3];
                TLIST[me0 * 16384 + p0] = tok; TLIST[me1 * 16384 + p1] = tok;
                TOKE[tok * 2] = me0; TOKE[tok * 2 + 1] = me1; TOKP[tok * 2] = p0; TOKP[tok * 2 + 1] = p1; TOKG[tok * 2] = ((const LAS float*)ri)[4]; TOKG[tok * 2 + 1] = ((const LAS float*)ri)[5];
            }
        }
#undef G_LOADROWS
        SEAM(pb + 5);

        for (int rep_ = 0; rep_ < REPS(8); ++rep_) if (EN(8) && IN(pb + 6)) {
            PH_BEGIN();
            const int ntiles = build_tile_table(F, l);
            run_gemm_gu(F.lds, ws, (unsigned*)(ws + WS_CTL) + CW_TILE + l * 4096, ntiles, G, bid, tid);
        }
#if TS_ENABLE
        if (INS(pb + 6)) { __syncthreads(); if (threadIdx.x == 0) { unsigned* ts_ = (unsigned*)(args.ws + WS_CTL) + CW_TS + 4 * (pb + 6); const unsigned t_ = (unsigned)__builtin_amdgcn_s_memrealtime(); atomicMax(ts_ + 1, t_); atomicAdd((unsigned long long*)(ts_ + 2), (unsigned long long)t_); } }
#endif

        for (int rep_ = 0; rep_ < REPS(9); ++rep_) if (EN(9) && IN(pb + 7)) {
            PH_BEGIN();
            const int ntiles = build_tile_table(F, l);
            run_gemm_dn(F.lds, ws, (unsigned*)(ws + WS_CTL) + CW_TILE + l * 4096, ntiles, G, bid, tid);
        }
        SEAM(pb + 7);

        for (int rep_ = 0; rep_ < REPS(10); ++rep_) if (EN(10) && IN(pb + 8)) {
            PH_BEGIN();
            (void)build_tile_table(F, l);
            const LAS int* tt = (const LAS int*)(F.lds + LDS_TT);
            if (l + 1 < DEPTH) {
                LAS float* scr = (LAS float*)(F.lds + wave * 16384);
                for (int it = gw; it < 24576; it += NGW) conv_moe_item(F, l + 1, it, scr);
                __syncthreads();
                load_wif(F, l + 1, (LAS float*)F.lds);
                __syncthreads();
            }
            LAS float* vecs = (LAS float*)(F.lds + 65536);
            {
                const float* lng = args.in[(I_LNG) + zoff] + (size_t)(l * 2 + 1) * D; const float* lnb = args.in[(I_LNB) + zoff] + (size_t)(l * 2 + 1) * D;
                for (int i = tid; i < 1024; i += 512) { vecs[i] = ada[5120 + i]; vecs[1024 + i] = lng[i]; vecs[2048 + i] = lnb[i];
                    if (l + 1 < DEPTH) { vecs[3072 + i] = ADA[(l + 1) * 6144 + i]; vecs[4096 + i] = 1.0f + ADA[(l + 1) * 6144 + 1024 + i]; } }
                __syncthreads();
            }
            {
                int ie0 = 0, ie1 = 0, ip0 = 0, ip1 = 0; float ig0 = 0.f, ig1 = 0.f;
                int ce0 = 0, ce1 = 0, cp0 = 0, cp1 = 0; float cg0 = 0.f, cg1 = 0.f;
                u32x2 ya[4], yb[4], xr[4]; float ng0 = 0.f, ng1 = 0.f;
#define J_INFO(ROW, E0, E1, P0, P1, G0, G1) do { E0 = TOKE[(ROW) * 2]; E1 = TOKE[(ROW) * 2 + 1]; P0 = TOKP[(ROW) * 2]; P1 = TOKP[(ROW) * 2 + 1]; G0 = TOKG[(ROW) * 2]; G1 = TOKG[(ROW) * 2 + 1]; } while (0)
#define J_DATA(ROW, E0, E1, P0, P1) do { const int j0_ = (P0) >> 8, j1_ = (P1) >> 8; \
        const size_t r0_ = (size_t)((j0_ < tt[225 + (E0)]) ? tt[32 + (E0)] + j0_ : tt[257 + (E0)]) * 256 + ((P0) & 255), r1_ = (size_t)((j1_ < tt[225 + (E1)]) ? tt[32 + (E1)] + j1_ : tt[257 + (E1)]) * 256 + ((P1) & 255); \
        _Pragma("unroll") for (int j = 0; j < 4; ++j) { const int k = 256 * j + 4 * lane; ya[j] = *(const u32x2*)(YB + r0_ * D + k); yb[j] = *(const u32x2*)(YB + r1_ * D + k); xr[j] = *(const u32x2*)(XB + (size_t)(ROW) * D + k); } } while (0)
                if (gw < S) { J_INFO(gw, ce0, ce1, cp0, cp1, cg0, cg1); J_DATA(gw, ce0, ce1, cp0, cp1); ng0 = cg0; ng1 = cg1; }
                if (gw + NGW < S) J_INFO(gw + NGW, ce0, ce1, cp0, cp1, cg0, cg1);
#pragma unroll 1
                for (int row = gw; row < S; row += NGW) {
                    const float g0 = ng0, g1 = ng1;
                    f32x4 v[4];
#pragma unroll
                    for (int j = 0; j < 4; ++j) { const int k = 256 * j + 4 * lane;
                        f32x4 y; y.x = g0 * bflo(ya[j].x) + g1 * bflo(yb[j].x); y.y = g0 * bfhi(ya[j].x) + g1 * bfhi(yb[j].x); y.z = g0 * bflo(ya[j].y) + g1 * bflo(yb[j].y); y.w = g0 * bfhi(ya[j].y) + g1 * bfhi(yb[j].y);
                        f32x4 xv; xv.x = bflo(xr[j].x); xv.y = bfhi(xr[j].x); xv.z = bflo(xr[j].y); xv.w = bfhi(xr[j].y); const f32x4 g2 = *(const LAS f32x4*)(vecs + k);
                        v[j] = xv * ALPHA + g2 * y; }
                    if (row + NGW < S) { J_DATA(row + NGW, ce0, ce1, cp0, cp1); ng0 = cg0; ng1 = cg1; }
                    if (row + 2 * NGW < S) J_INFO(row + 2 * NGW, ce0, ce1, cp0, cp1, cg0, cg1);
                    ln_row(v);
#pragma unroll
                    for (int j = 0; j < 4; ++j) { const int k = 256 * j + 4 * lane; v[j] = v[j] * *(const LAS f32x4*)(vecs + 1024 + k) + *(const LAS f32x4*)(vecs + 2048 + k);
                        if constexpr (L + 1 < DEPTH) { u32x2 xw; xw.x = pk2(v[j].x, v[j].y); xw.y = pk2(v[j].z, v[j].w); *(u32x2*)(XB + (size_t)row * D + k) = xw; } else *(f32x4*)(args.out + (size_t)row * D + k) = v[j]; }
                    if (l + 1 < DEPTH) {
                        ln_row(v);
                        emit_u(F, v, vecs + 3072, vecs + 4096, row, (const LAS float*)F.lds, args.in[(I_BIN) + zoff] + (size_t)(l + 1) * NIN + 4096);
                    }
                }
#undef J_INFO
#undef J_DATA
                (void)ie0; (void)ie1; (void)ip0; (void)ip1; (void)ig0; (void)ig1;
            }
        }
        SEAM(pb + 8);
}

__global__ void __launch_bounds__(512, 2) fwd(Args args) {
    extern __shared__ __attribute__((aligned(16))) unsigned char lds_raw[];
    Frame F;
    F.lds = (LAS unsigned char*)lds_raw;
    F.tid = threadIdx.x; F.lane = F.tid & 63; F.wave = __builtin_amdgcn_readfirstlane(F.tid >> 6);
    F.G = gridDim.x; F.bid = blockIdx.x;
    F.in = args.in; F.out = args.out; F.ws = args.ws; F.zoff = 0; F.pflags = args.pflags;
    const int tid0 = threadIdx.x;
    unsigned char* ws0 = args.ws;
    const int lo = args.ph_lo, hi = args.ph_hi;
    volatile LAS unsigned* MISC = (volatile LAS unsigned*)(F.lds + LDS_MISC);
    if (tid0 < 64) MISC[tid0] = 0u;
    __syncthreads();
    XcdBarrier bar; bar.bar = (unsigned*)(ws0 + WS_CTL) + CW_BAR; bar.x = 0; bar.st = MISC + 8;
#if TS_ENABLE
    if (blockIdx.x == 0 && threadIdx.x == 0 && args.ph_lo == 0) ((unsigned*)(args.ws + WS_CTL))[CW_TS + 512] = (unsigned)__builtin_amdgcn_s_memrealtime();
#endif
    const bool multi = (hi - lo) > 1;
    if (multi) bar = xcd_barrier_post((unsigned*)(ws0 + WS_CTL) + CW_BAR, MISC + 8);
    for (int rep_ = 0; rep_ < REPS(0); ++rep_) if (EN(0) && IN(0)) {
        PH_BEGIN();
        unsigned* ada_cnt = (unsigned*)(ws + WS_CTL) + CW_ADA;
        {
            LAS float* red = (LAS float*)F.lds;
            const float* c = args.in[(I_C) + zoff];
            for (int g = bid; g < 256; g += G) {
                const int l = g >> 7, n0 = (g & 127) * 48, c4 = tid % 12, kq = tid / 12;
                if (kq < 42) {
                    const float* w = args.in[(I_WADA) + zoff] + (size_t)l * D * 6144 + n0 + c4 * 4;
                    f32x4 acc = {0.f, 0.f, 0.f, 0.f};
#pragma unroll 5
                    for (int k = kq; k < D; k += 42) { const float cv = silu_f(c[k]); const f32x4 wv = *(const f32x4*)(w + (size_t)k * 6144); acc += wv * cv; }
                    *(LAS f32x4*)(red + kq * 48 + c4 * 4) = acc;
                }
                __syncthreads();
                if (tid < 48) { float s = 0.f; for (int q = 0; q < 42; ++q) s += red[q * 48 + tid];
                    __hip_atomic_store(ADA + l * 6144 + n0 + tid, s + args.in[(I_BADA) + zoff][l * 6144 + n0 + tid], __ATOMIC_RELAXED, __HIP_MEMORY_SCOPE_AGENT);
                    asm volatile("s_waitcnt vmcnt(0)" ::: "memory");
                    if (tid == 0 && rep_ == 0) __hip_atomic_fetch_add(ada_cnt, 1u, __ATOMIC_RELAXED, __HIP_MEMORY_SCOPE_AGENT); }
                __syncthreads();
            }
        }
#if TS_ENABLE
        { __syncthreads(); if (threadIdx.x == 0) { unsigned* ts_ = (unsigned*)(args.ws + WS_CTL) + CW_TS + 4 * (20); const unsigned t_ = (unsigned)__builtin_amdgcn_s_memrealtime(); atomicMax(ts_ + 1, t_); atomicAdd((unsigned long long*)(ts_ + 2), (unsigned long long)t_); } }
#endif
        LAS float* scr = (LAS float*)(F.lds + wave * 16384);
        for (int it = gw; it < 2 * 4224; it += NGW) conv_dense_item(F, it, scr);
        for (int it = gw; it < 24576; it += NGW) conv_moe_item(F, 0, it, scr);
#if TS_ENABLE
        { __syncthreads(); if (threadIdx.x == 0) { unsigned* ts_ = (unsigned*)(args.ws + WS_CTL) + CW_TS + 4 * (21); const unsigned t_ = (unsigned)__builtin_amdgcn_s_memrealtime(); atomicMax(ts_ + 1, t_); atomicAdd((unsigned long long*)(ts_ + 2), (unsigned long long)t_); } }
#endif
        __syncthreads();
        if (tid == 0) { unsigned sp = 0; while (__hip_atomic_load(ada_cnt, __ATOMIC_RELAXED, __HIP_MEMORY_SCOPE_AGENT) < 256u) { __builtin_amdgcn_s_sleep(2); if (++sp > (1u << 22)) break; }
            __builtin_amdgcn_fence(__ATOMIC_ACQUIRE, "agent"); asm volatile("s_waitcnt vmcnt(0)" ::: "memory"); }
        __syncthreads();
        LAS float* Wif = (LAS float*)F.lds;
        load_wif(F, 0, Wif);
        LAS float* vecs = (LAS float*)(F.lds + 65536);
        for (int i = tid; i < 1024; i += 512) { vecs[i] = ADA[i]; vecs[1024 + i] = 1.0f + ADA[1024 + i]; }
        __syncthreads();
        const float* x = args.in[(I_X) + zoff];
        {
            f32x4 xn[4];
            if (gw < S) {
#pragma unroll
                for (int j = 0; j < 4; ++j) xn[j] = *(const f32x4*)(x + (size_t)gw * D + 256 * j + 4 * lane); }
#pragma unroll 1
            for (int row = gw; row < S; row += NGW) {
                f32x4 v[4];
#pragma unroll
                for (int j = 0; j < 4; ++j) v[j] = xn[j];
                if (row + NGW < S) {
#pragma unroll
                    for (int j = 0; j < 4; ++j) xn[j] = *(const f32x4*)(x + (size_t)(row + NGW) * D + 256 * j + 4 * lane); }
                ln_row(v);
                emit_u(F, v, vecs, vecs + 1024, row, Wif, args.in[(I_BIN) + zoff] + 4096);
            }
        }
    }
    SEAM(1);

    layer_phases<0>(args, F, bar, lo, hi);
    layer_phases<1>(args, F, bar, lo, hi);
#undef IN
#undef INS
#undef SEAM
}

#if TS_ENABLE
__global__ void ts_spin(const unsigned* ctl) {
    const unsigned* ts = ctl + CW_TS; const int seams[] = {1, 2, 3, 4, 5, 6, 7, 9, 10, 11, 12, 13, 14, 15, 16, 18, 19};
    long long v = 0;
    if (TS_SEL == 1) { for (int i = 0; i < 17; ++i) { const int k = seams[i]; const unsigned long long sum = *(const unsigned long long*)(ts + 4 * k + 2); v += (long long)ts[4 * k + 1] - (long long)(sum / gridDim.y); } }
    else if (TS_SEL == 2) { for (int i = 0; i < 17; ++i) { const int k = seams[i]; v += (long long)ts[4 * k] - (long long)ts[4 * k + 1]; } }
    else if (TS_SEL >= 100 && TS_SEL < 200) { const int k = TS_SEL - 100; int kp = k - 1; while (kp > 0 && ts[4 * kp] == 0u) --kp; const unsigned prev = (kp <= 0 || ts[4 * kp] == 0u) ? ts[512] : ts[4 * kp]; v = (long long)ts[4 * k] - (long long)prev; }
    else if (TS_SEL >= 500) { const int k = (TS_SEL >= 600) ? TS_SEL - 600 : TS_SEL - 500; const unsigned long long sum = *(const unsigned long long*)(ts + 4 * k + 2); v = (TS_SEL >= 600) ? (long long)(sum / gridDim.y) - (long long)ts[512] : (long long)ts[4 * k + 1] - (long long)ts[512]; }
    else if (TS_SEL >= 300) { const int k = (TS_SEL >= 400) ? TS_SEL - 400 : TS_SEL - 300; int kp = k - 1; while (kp > 0 && ts[4 * kp] == 0u) --kp; const unsigned prev = (kp <= 0 || ts[4 * kp] == 0u) ? ts[512] : ts[4 * kp];
        const unsigned long long sum = *(const unsigned long long*)(ts + 4 * k + 2); v = (TS_SEL >= 400) ? (long long)(sum / gridDim.y) - (long long)prev : (long long)ts[4 * k + 1] - (long long)prev; }
    else if (TS_SEL >= 200) { const int k = TS_SEL - 200; const unsigned long long sum = *(const unsigned long long*)(ts + 4 * k + 2); v = (long long)ts[4 * k + 1] - (long long)(sum / gridDim.y); }
    if (v < 0) v = 0; if (v > 2000000) v = 2000000;
    const unsigned long long t0 = __builtin_amdgcn_s_memrealtime(), need = (unsigned long long)v * TS_AMP;
    while (__builtin_amdgcn_s_memrealtime() - t0 < need) __builtin_amdgcn_s_sleep(4);
}
#endif
#ifndef TS_ENABLE
#define TS_ENABLE 0
#endif
#ifndef TS_SEL
#define TS_SEL 0
#endif
#ifndef TS_AMP
#define TS_AMP 10
#endif
#ifndef PROBE_PHASE
#define PROBE_PHASE -1
#endif
#ifndef PROBE_FLAGS
#define PROBE_FLAGS 0
#endif
#ifndef PROBE_SPAN
#define PROBE_SPAN 0
#endif
#ifndef N_LAUNCH_MODE
#define N_LAUNCH_MODE 1
#endif
extern "C" void kernel_launch(void* const* d_in, const int* in_sizes, int n_in, void* d_out, int out_size, void* d_ws, size_t ws_size, hipStream_t stream) {
    static int grid = 0;
    if (grid == 0) {
        if (n_in != 25 || out_size != S * D || ws_size < WS_END) { fprintf(stderr, "kernel_launch: unexpected shapes: n_in %d out %d ws %zu\n", n_in, out_size, ws_size); grid = -1; return; }
        int dev = 0, cus = 0;
        if (hipGetDevice(&dev) != hipSuccess || hipDeviceGetAttribute(&cus, hipDeviceAttributeMultiprocessorCount, dev) != hipSuccess) { grid = -1; return; }
        if (hipFuncSetAttribute((const void*)fwd, hipFuncAttributeMaxDynamicSharedMemorySize, LDS_BYTES) != hipSuccess) { fprintf(stderr, "kernel_launch: hipFuncSetAttribute failed\n"); grid = -1; return; }
        int per_cu = 0;
        if (hipOccupancyMaxActiveBlocksPerMultiprocessor(&per_cu, (const void*)fwd, 512, LDS_BYTES) != hipSuccess || per_cu < 1) fprintf(stderr, "kernel_launch: occupancy query says %d\n", per_cu);
        (void)hipGetLastError();
        grid = cus;
    }
    if (grid < 0) return;
    (void)hipMemsetAsync((char*)d_ws + WS_CTL, 0, CTL_BYTES, stream);
    Args a{};
    for (int i = 0; i < 25; ++i) a.in[i] = (const float*)d_in[i];
    a.out = (float*)d_out; a.ws = (unsigned char*)d_ws;
#if N_LAUNCH_MODE == 1
    a.ph_lo = 0; a.ph_hi = NPH;
    hipLaunchKernelGGL(fwd, dim3(grid), dim3(512), LDS_BYTES, stream, a);
#if TS_ENABLE
    hipLaunchKernelGGL(ts_spin, dim3(1, grid), dim3(1), 0, stream, (const unsigned*)((unsigned char*)d_ws + WS_CTL));
#endif
#if PROBE_PHASE >= 0
    a.ph_lo = PROBE_PHASE; a.ph_hi = PROBE_PHASE + 1 + PROBE_SPAN; a.out = (float*)((unsigned char*)d_ws + WS_B); a.pflags = PROBE_FLAGS;
    (void)hipMemsetAsync((char*)d_ws + WS_CTL, 0, CTL_BYTES, stream);
    hipLaunchKernelGGL(fwd, dim3(grid), dim3(512), LDS_BYTES, stream, a);
#endif
#else
    for (int ph = 0; ph < NPH; ++ph) { a.ph_lo = ph; a.ph_hi = ph + 1; hipLaunchKernelGGL(fwd, dim3(grid), dim3(512), LDS_BYTES, stream, a); }
#endif
}
```

```cpp
#include <hip/hip_runtime.h>
#include <cstdio>
#include <cstdint>

#define GAS __attribute__((address_space(1)))
#define LAS __attribute__((address_space(3)))
typedef unsigned short bf16;
typedef float f32x4 __attribute__((ext_vector_type(4)));
typedef float f32x2 __attribute__((ext_vector_type(2)));
typedef short bf16x8 __attribute__((ext_vector_type(8)));
typedef unsigned u32x4 __attribute__((ext_vector_type(4)));
typedef unsigned u32x2 __attribute__((ext_vector_type(2)));

#ifndef TS_ENABLE
#define TS_ENABLE 0
#endif
#ifndef TS_SEL
#define TS_SEL 0
#endif
#ifndef TS_AMP
#define TS_AMP 10
#endif
#ifndef TS_REF
#define TS_REF 0
#endif
#if TS_ENABLE
#define TS_POINT(k) do { __syncthreads(); if (threadIdx.x == 0) { unsigned* ts_ = (unsigned*)(args.ws + WS_CTL) + CW_TS + 4 * (k); const unsigned t_ = (unsigned)__builtin_amdgcn_s_memrealtime(); atomicMax(ts_ + 1, t_); atomicAdd((unsigned long long*)(ts_ + 2), (unsigned long long)t_); } } while (0)
#else
#define TS_POINT(k) do { } while (0)
#endif
constexpr int S = 16384, D = 1024, DEPTH = 2, NH = 8, DH = 128, CH = 128, NC = S / CH, NE = 32, DFF = 512;
constexpr int NIN = 6160, NPROJ = 6144;
constexpr float LN_EPS = 1e-5f;
constexpr float ALPHA = 1.41421356237f;
constexpr int NPH = 2 + 9 * DEPTH;

constexpr size_t MiB = 1u << 20;
constexpr size_t WS_CTL = 0, CTL_BYTES = 131072;
constexpr size_t WS_ADA = 1 * MiB;
constexpr size_t WS_IFG = 2 * MiB;
constexpr size_t WS_BCUM = 3 * MiB;
constexpr size_t WS_CHS = 3 * MiB + 512 * 1024;
constexpr size_t WS_MST = WS_CHS + 16384;
constexpr size_t WS_NLOC = 4 * MiB;
constexpr size_t WS_NST = 4 * MiB + 512 * 1024;
constexpr size_t WS_AC = 5 * MiB;
constexpr size_t WS_HC = 5 * MiB + 512 * 1024;
constexpr size_t WS_TOKE = 6 * MiB;
constexpr size_t WS_TOKP = 6 * MiB + 256 * 1024;
constexpr size_t WS_TOKG = 6 * MiB + 512 * 1024;
constexpr size_t WS_TLIST = 7 * MiB;
constexpr size_t WS_WIN = 10 * MiB;
constexpr size_t WS_WOUT = 34 * MiB;
constexpr size_t WS_WAX = 42 * MiB;
constexpr size_t WS_WGU = 44 * MiB;
constexpr size_t WS_WDN = 108 * MiB;
constexpr size_t WS_U = 140 * MiB;
constexpr size_t WS_A = 172 * MiB;
constexpr size_t WS_V = 236 * MiB;
constexpr size_t WS_O = 268 * MiB;
constexpr size_t WS_XR = 300 * MiB;
constexpr size_t WS_GR = 332 * MiB;
constexpr size_t WS_B = 364 * MiB;
constexpr size_t WS_UC = 428 * MiB;
constexpr size_t WS_HLOC = 460 * MiB;
constexpr size_t WS_PCUM = 492 * MiB;
constexpr size_t WS_XB = 524 * MiB;
constexpr size_t WS_END = 556 * MiB;
constexpr size_t WS_HID = WS_V;
constexpr size_t WS_YB = WS_V + 40 * MiB;
static_assert(WS_YB + (size_t)40960 * 1024 * 2 <= WS_B, "moe overlay");

constexpr int CW_BAR = 4096;
constexpr int CW_ADA = 2048;
constexpr int CW_TILE = 16384;
constexpr int CW_TS = 24576;
constexpr int CW_CNT = 8192;

constexpr int LDS_SCR = 143360;
constexpr int LDS_TT = 143360;
constexpr int LDS_MISC = 144896;
constexpr int LDS_BYTES = 147456;

__device__ __forceinline__ float bf2f(unsigned b) { return __uint_as_float(b << 16); }
__device__ __forceinline__ float bflo(unsigned w) { return __uint_as_float(w << 16); }
__device__ __forceinline__ float bfhi(unsigned w) { return __uint_as_float(w & 0xffff0000u); }
__device__ __forceinline__ unsigned f2bf(float f) { unsigned u = __float_as_uint(f); return (u + 0x7fffu + ((u >> 16) & 1u)) >> 16; }
typedef __bf16 bf16x2_t __attribute__((ext_vector_type(2)));
__device__ __forceinline__ unsigned pk2(float lo, float hi) { const f32x2 v = {lo, hi}; return __builtin_bit_cast(unsigned, __builtin_convertvector(v, bf16x2_t)); }
__device__ __forceinline__ float rbf(float f) { return bf2f(f2bf(f)); }
template <int CTRL> __device__ __forceinline__ float dpp_mov(float x) { return __builtin_bit_cast(float, __builtin_amdgcn_mov_dpp(__builtin_bit_cast(int, x), CTRL, 0xf, 0xf, true)); }
__device__ __forceinline__ float wave_sum(float v) {
    v += dpp_mov<0xB1>(v); v += dpp_mov<0x4E>(v); v += dpp_mov<0x141>(v); v += dpp_mov<0x128>(v);
    const auto s = __builtin_amdgcn_permlane16_swap(__float_as_uint(v), __float_as_uint(v), false, false); v = __uint_as_float(s[0]) + __uint_as_float(s[1]);
    const auto t = __builtin_amdgcn_permlane32_swap(__float_as_uint(v), __float_as_uint(v), false, false); return __uint_as_float(t[0]) + __uint_as_float(t[1]);
}
__device__ __forceinline__ float wave_max(float v) {
    v = fmaxf(v, dpp_mov<0xB1>(v)); v = fmaxf(v, dpp_mov<0x4E>(v)); v = fmaxf(v, dpp_mov<0x141>(v)); v = fmaxf(v, dpp_mov<0x128>(v));
    const auto s = __builtin_amdgcn_permlane16_swap(__float_as_uint(v), __float_as_uint(v), false, false); v = fmaxf(__uint_as_float(s[0]), __uint_as_float(s[1]));
    const auto t = __builtin_amdgcn_permlane32_swap(__float_as_uint(v), __float_as_uint(v), false, false); return fmaxf(__uint_as_float(t[0]), __uint_as_float(t[1]));
}
__device__ __forceinline__ float row16_sum(float v) { v += dpp_mov<0xB1>(v); v += dpp_mov<0x4E>(v); v += dpp_mov<0x141>(v); v += dpp_mov<0x128>(v); return v; }
__device__ __forceinline__ float xrow_sum(float v) {
    const auto s = __builtin_amdgcn_permlane16_swap(__float_as_uint(v), __float_as_uint(v), false, false); v = __uint_as_float(s[0]) + __uint_as_float(s[1]);
    const auto t = __builtin_amdgcn_permlane32_swap(__float_as_uint(v), __float_as_uint(v), false, false); return __uint_as_float(t[0]) + __uint_as_float(t[1]); }
__device__ __forceinline__ float reduce16_scatter(float (&v)[16], int lane) {
#pragma unroll
    for (int i = 0; i < 8; ++i) { const auto r = __builtin_amdgcn_permlane32_swap(__float_as_uint(v[i]), __float_as_uint(v[i + 8]), false, false); v[i] = __uint_as_float(r[0]) + __uint_as_float(r[1]); }
#pragma unroll
    for (int i = 0; i < 4; ++i) { const auto r = __builtin_amdgcn_permlane16_swap(__float_as_uint(v[i]), __float_as_uint(v[i + 4]), false, false); v[i] = __uint_as_float(r[0]) + __uint_as_float(r[1]); }
    const float t0 = row16_sum(v[0]), t1 = row16_sum(v[1]), t2 = row16_sum(v[2]), t3 = row16_sum(v[3]);
    const int li = lane & 3;
    return li == 0 ? t0 : li == 1 ? t1 : li == 2 ? t2 : t3;
}
template <int CTRL> __device__ __forceinline__ float dpp_upd(float old, float x) { return __builtin_bit_cast(float, __builtin_amdgcn_update_dpp(__builtin_bit_cast(int, old), __builtin_bit_cast(int, x), CTRL, 0xf, 0xf, false)); }
__device__ __forceinline__ float rdlane(float v, int l) { return __builtin_bit_cast(float, __builtin_amdgcn_readlane(__builtin_bit_cast(int, v), l)); }
__device__ __forceinline__ float wave_scan_sum(float v, int lane) {
    v += dpp_upd<0x111>(0.f, v); v += dpp_upd<0x112>(0.f, v); v += dpp_upd<0x114>(0.f, v); v += dpp_upd<0x118>(0.f, v);
    const float r0 = rdlane(v, 15), r1 = rdlane(v, 31), r2 = rdlane(v, 47); const int row = lane >> 4;
    return v + ((row >= 1 ? r0 : 0.f) + (row >= 2 ? r1 : 0.f) + (row >= 3 ? r2 : 0.f));
}
__device__ __forceinline__ float wave_scan_max(float v, int lane) {
    constexpr float NEG = -3.0e38f;
    v = fmaxf(v, dpp_upd<0x111>(NEG, v)); v = fmaxf(v, dpp_upd<0x112>(NEG, v)); v = fmaxf(v, dpp_upd<0x114>(NEG, v)); v = fmaxf(v, dpp_upd<0x118>(NEG, v));
    const float r0 = rdlane(v, 15), r1 = rdlane(v, 31), r2 = rdlane(v, 47); const int row = lane >> 4;
    return fmaxf(v, fmaxf(row >= 1 ? r0 : NEG, fmaxf(row >= 2 ? r1 : NEG, row >= 3 ? r2 : NEG)));
}
__device__ __forceinline__ float fast_exp(float x) { return __builtin_amdgcn_exp2f(x * 1.4426950408889634f); }
__device__ __forceinline__ float fast_rcp(float x) { return __builtin_amdgcn_rcpf(x); }
__device__ __forceinline__ float sigmoid_f(float x) { return fast_rcp(1.f + fast_exp(-x)); }
__device__ __forceinline__ float silu_f(float x) { return x * fast_rcp(1.f + fast_exp(-x)); }
__device__ __forceinline__ float gelu_tanh_f(float x) { const float u = 0.7978845608f * (x + 0.044715f * x * x * x); const float t = 1.f - 2.f * fast_rcp(1.f + fast_exp(2.f * u)); return 0.5f * x * (1.f + t); }
__device__ __forceinline__ float logsigmoid_f(float x) { return fminf(x, 0.f) - log1pf(__expf(-fabsf(x))); }
__device__ __forceinline__ float softplus_f(float x) { return fmaxf(x, 0.f) + log1pf(__expf(-fabsf(x))); }

__device__ __forceinline__ void st16_wt(void* p, u32x4 v) { asm volatile("global_store_dwordx4 %0, %1, off sc1\n\ts_nop 1" :: "v"(p), "v"(v) : "memory"); }
__device__ __forceinline__ void st16_wt(void* p, f32x4 v) { asm volatile("global_store_dwordx4 %0, %1, off sc1\n\ts_nop 1" :: "v"(p), "v"(v) : "memory"); }

__device__ __forceinline__ void lds_barrier() { asm volatile("s_waitcnt lgkmcnt(0)" ::: "memory"); __builtin_amdgcn_s_barrier(); asm volatile("" ::: "memory"); }

#define XB_TMO      128
#define XB_XCNT(j)  (256  + 64 * (j))
#define XB_XSUB(j)  (1280 + 64 * (j))
#define XB_XGEN(j)  (2304 + 64 * (j))
#define XB_TOP      3328
#define XB_TOPGEN   3392
#define XCD_BAR_WORDS 3456
#define XB_SPIN_CAP (1u << 18)

__device__ __forceinline__ unsigned xb_ld(unsigned* p)              { return __hip_atomic_load(p, __ATOMIC_RELAXED, __HIP_MEMORY_SCOPE_AGENT); }
__device__ __forceinline__ unsigned xb_add(unsigned* p, unsigned v) { return __hip_atomic_fetch_add(p, v, __ATOMIC_RELAXED, __HIP_MEMORY_SCOPE_AGENT); }
__device__ __forceinline__ unsigned xb_xcc_id() { return (unsigned)__builtin_amdgcn_s_getreg((3 << 11) | 20) & 0xFu; }
#define XB_SPIN(cond, bar) do { unsigned _sp = 0; while (cond) { __builtin_amdgcn_s_sleep(1); \
    if ((++_sp & 255u) == 0u) { if (xb_ld(&(bar)[XB_TMO])) break; if (_sp > XB_SPIN_CAP) { atomicAdd(&(bar)[XB_TMO], 1u); break; } } } } while (0)

struct XcdBarrier { unsigned* bar; unsigned x; volatile LAS unsigned* st; };

__device__ __forceinline__ XcdBarrier xcd_barrier_post(unsigned* bar, volatile LAS unsigned* st) {
    XcdBarrier b; b.bar = bar; b.x = xb_xcc_id(); b.st = st;
    if (threadIdx.x == 0) (void)xb_add(&bar[XB_XCNT(b.x)], 1u);
    return b;
}
__device__ __forceinline__ void xcd_barrier_complete(unsigned* bar, unsigned x, unsigned& nloc, unsigned& nx) {
    const unsigned G = gridDim.x * gridDim.y * gridDim.z;
    unsigned sum, cnt, mine, sp = 0u;
    for (;;) {
        sum = 0u; cnt = 0u; mine = 0u;
#pragma unroll
        for (unsigned j = 0; j < 16; ++j) { const unsigned c = xb_ld(&bar[XB_XCNT(j)]); sum += c; cnt += (c > 0u) ? 1u : 0u; mine = (j == x) ? c : mine; }
        if (sum == G) break;
        __builtin_amdgcn_s_sleep(1);
        if ((++sp & 255u) == 0u) { if (xb_ld(&bar[XB_TMO])) break; if (sp > XB_SPIN_CAP) { atomicAdd(&bar[XB_TMO], 1u); break; } }
    }
    nloc = mine > 0u ? mine : 1u; nx = cnt > 0u ? cnt : 1u;
}
__device__ __attribute__((noinline)) void xcd_barrier_impl(unsigned* bbar, unsigned bx, volatile LAS unsigned* bst) {
    XcdBarrier b; b.bar = bbar; b.x = bx; b.st = bst;
    asm volatile("s_waitcnt vmcnt(0)" ::: "memory");
    __syncthreads();
    if (threadIdx.x == 0) {
        unsigned* bar = b.bar;
        __builtin_amdgcn_s_waitcnt(0);
        unsigned nloc = b.st[0], nx = b.st[1];
        if (nloc == 0u) { xcd_barrier_complete(bar, b.x, nloc, nx); b.st[0] = nloc; b.st[1] = nx; }
        const unsigned old = xb_add(&bar[XB_XSUB(b.x)], 1u);
        const unsigned gen = old / nloc;
        if (old + 1u == (gen + 1u) * nloc) {
            __builtin_amdgcn_fence(__ATOMIC_RELEASE, "agent");
            asm volatile("s_waitcnt vmcnt(0)" ::: "memory");
            const unsigned og = xb_add(&bar[XB_TOP], 1u);
            const unsigned tg = og / nx;
            if (og + 1u == (tg + 1u) * nx) xb_add(&bar[XB_TOPGEN], 1u);
            else XB_SPIN(xb_ld(&bar[XB_TOPGEN]) == tg, bar);
            __builtin_amdgcn_fence(__ATOMIC_ACQUIRE, "agent");
            asm volatile("s_waitcnt vmcnt(0)" ::: "memory");
        } else {
            XB_SPIN(xb_ld(&bar[XB_TOPGEN]) == gen, bar);
            __builtin_amdgcn_fence(__ATOMIC_ACQUIRE, "agent");
            asm volatile("s_waitcnt vmcnt(0)" ::: "memory");
        }
    }
    __syncthreads();
}

namespace pg8 {
constexpr int BM = 256, BK = 64, HALF = 128, HTB = HALF * BK * 2, STAGE_BYTES = 8 * HTB, NXCD = 8, WGM = 8;
__host__ __device__ __forceinline__ int lds_byte(int r, int c) { const int st = (r >> 4) * 2 + (c >> 5), rr = r & 15, cc = c & 31, ob = rr * 64 + cc * 2; return st * 1024 + (ob ^ (((ob >> 9) & 1) << 5)); }
__host__ __device__ __forceinline__ void stage_rc(int b, int& R, int& C) { const int st = b / 1024, sb = b % 1024, swz = sb ^ (((sb >> 9) & 1) << 5); R = (st >> 1) * 16 + swz / 64; C = (st & 1) * 32 + (swz % 64) / 2; }
__host__ __device__ __forceinline__ int perm32(int rho) { const int n = rho >> 4, i = rho & 15; return 8 * (i >> 2) + 4 * n + (i & 3); }

struct Unit { int pm, pn, e, j, half; };

struct DenseOrder {
    static constexpr bool HOOKS = false;
    int nM, nN, nwg, G, c;
    __device__ __forceinline__ void init(int M, int N, int G_, int c_) { nM = M / BM; nN = N / BM; nwg = nM * nN; G = G_; c = c_; }
    __device__ __forceinline__ bool next(int i, Unit& u) const {
        const long L = (long)i * G + c; if (L >= nwg) return false;
        int wgid = (int)L; { const int q = nwg / NXCD, r = nwg % NXCD, xcd = wgid % NXCD, off = wgid / NXCD; wgid = (xcd < r ? xcd * (q + 1) : r * (q + 1) + (xcd - r) * q) + off; }
        const int nig = WGM * nN, gid = wgid / nig, fm = gid * WGM, gsz = (nM - fm) < WGM ? (nM - fm) : WGM;
        u.pm = fm + ((wgid % nig) % gsz); u.pn = (wgid % nig) / gsz; u.e = 0; u.j = 0; u.half = 0; return true;
    }
    __device__ __forceinline__ size_t a_base(const Unit& u, int K) const { return (size_t)u.pm * 256 * K * 2; }
    __device__ __forceinline__ size_t b_base(const Unit& u, int K) const { return (size_t)u.pn * 256 * K * 2; }
    __device__ __forceinline__ void a_offs(const Unit&, int, const int (&)[2], const int (&)[2], unsigned (&)[4]) const {}
    __device__ __forceinline__ void a_toks(const Unit&, const int (&)[2], unsigned (&)[4]) const {}
    __device__ __forceinline__ void a_fin(const unsigned (&)[4], int, const int (&)[2], unsigned (&)[4]) const {}
    __device__ __forceinline__ void a_ready(const Unit&, int) const {}
    __device__ __forceinline__ void done(int, int) const {}
};
struct MoeOrder {
    static constexpr bool HOOKS = true;
    const LAS int* tt;
    const int* tlist;
    int ntiles, G, c; size_t estrideB;
    __device__ __forceinline__ bool next(int i, Unit& u) const {
        const int per = G >> 3, L = i * G + ((G & 7) ? c : (c & 7) * per + (c >> 3)); if (L >= ntiles * 4) return false;
        const int tau = L >> 2; u.pn = L & 3; u.pm = tau; const int t = tt[65 + tau]; u.e = t >> 16; u.j = t & 0x7fff; u.half = (t >> 15) & 1; return true;
    }
    __device__ __forceinline__ size_t a_base(const Unit& u, int K) const { return (size_t)u.pm * 256 * K * 2; }
    __device__ __forceinline__ size_t b_base(const Unit& u, int K) const { return (size_t)u.e * estrideB + (size_t)u.pn * 256 * K * 2; }
    __device__ __forceinline__ void a_offs(const Unit& u, int K, const int (&R)[2], const int (&C)[2], unsigned (&o)[4]) const {
        const int cnt = tt[u.e];
#pragma unroll
        for (int h = 0; h < 2; ++h)
#pragma unroll
            for (int i = 0; i < 2; ++i) { const int idx = u.j * 256 + h * 128 + R[i]; int tok = 0; if (idx < cnt) tok = tlist[u.e * 16384 + idx]; o[h * 2 + i] = (unsigned)(tok * K + C[i]) * 2u; }
    }
    __device__ __forceinline__ void a_toks(const Unit& u, const int (&R)[2], unsigned (&tk)[4]) const {
        const int cnt = tt[u.e];
#pragma unroll
        for (int h = 0; h < 2; ++h)
#pragma unroll
            for (int i = 0; i < 2; ++i) { int idx = u.j * 256 + h * 128 + R[i]; idx = idx < cnt ? idx : 0; const int* p = tlist + u.e * 16384 + idx;
                asm volatile("global_load_dword %0, %1, off" : "=v"(tk[h * 2 + i]) : "v"(p) : "memory"); }
    }
    __device__ __forceinline__ void a_fin(const unsigned (&tk)[4], int K, const int (&C)[2], unsigned (&o)[4]) const {
#pragma unroll
        for (int h = 0; h < 2; ++h)
#pragma unroll
            for (int i = 0; i < 2; ++i) o[h * 2 + i] = (tk[h * 2 + i] * (unsigned)K + (unsigned)C[i]) * 2u;
    }
    unsigned* tsbase;
    unsigned* tcnt; int mode;
    __device__ __forceinline__ void done(int pm, int lane) const {
        if (mode == 1 && lane == 0) __hip_atomic_fetch_add(tcnt + 16 * pm, 1u, __ATOMIC_RELAXED, __HIP_MEMORY_SCOPE_AGENT);
    }
    __device__ __forceinline__ void a_ready(const Unit& u, int wid) const {
        if (mode != 2) return;
        if (wid == 0) {
            unsigned sp = 0;
            while ((unsigned)__builtin_amdgcn_readfirstlane(__hip_atomic_load(tcnt + 16 * u.pm, __ATOMIC_RELAXED, __HIP_MEMORY_SCOPE_AGENT)) < 32u) { __builtin_amdgcn_s_sleep(2); if (++sp > (1u << 21)) break; }
            __builtin_amdgcn_fence(__ATOMIC_ACQUIRE, "agent");
            asm volatile("s_waitcnt vmcnt(0)" ::: "memory");
        }
        asm volatile("" ::: "memory"); __builtin_amdgcn_s_barrier(); asm volatile("" ::: "memory");
    }
};

__device__ __forceinline__ unsigned cvt_pk_bf16(float lo, float hi) { return pk2(lo, hi); }

struct EpiF32 {
    static constexpr bool PERM = false;
    float* C; int ldc;
    __device__ __forceinline__ void operator()(const f32x4 (&acc)[2][2][4][2], const Unit& u, int wr, int wc, int fr, int fq) const {
        const int row0 = u.pm * BM + wr * 64 + fr, col0 = u.pn * BM + wc * 32 + 4 * fq;
#pragma unroll
        for (int ai = 0; ai < 2; ++ai)
#pragma unroll
            for (int m = 0; m < 4; ++m) { float* rowp = C + (size_t)(row0 + ai * HALF + m * 16) * ldc + col0;
#pragma unroll
                for (int bj = 0; bj < 2; ++bj)
#pragma unroll
                    for (int n = 0; n < 2; ++n) st16_wt(rowp + bj * HALF + n * 16, acc[ai][bj][m][n]); }
    }
};
struct EpiProj {
    static constexpr bool PERM = true;
    bf16 *QK, *V, *O, *XR, *GR; const LAS bf16* bias;
    __device__ __forceinline__ void operator()(const f32x4 (&acc)[2][2][4][2], const Unit& u, int wr, int wc, int fr, int fq) const {
        const int pn = u.pn; bf16* base; int ldc, colt, bcol, act;
        if (pn < 8) { base = QK; ldc = 2048; colt = pn * 256; bcol = pn * 256; act = 0; }
        else if (pn < 12) { base = V; ldc = 1024; colt = (pn - 8) * 256; bcol = pn * 256; act = 0; }
        else if (pn < 16) { base = O; ldc = 1024; colt = (pn - 12) * 256; bcol = pn * 256; act = 1; }
        else if (pn < 20) { base = XR; ldc = 1024; colt = (pn - 16) * 256; bcol = pn * 256 + 16; act = 0; }
        else { base = GR; ldc = 1024; colt = (pn - 20) * 256; bcol = pn * 256 + 16; act = 2; }
        const int row0 = u.pm * BM + wr * 64 + fr, col0 = colt + wc * 32 + 8 * fq, bcol0 = bcol + wc * 32 + 8 * fq;
        f32x4 bv[2][2];
#pragma unroll
        for (int bj = 0; bj < 2; ++bj) { const u32x4 b8 = *(const LAS u32x4*)(bias + bcol0 + bj * HALF);
            bv[bj][0] = (f32x4){bflo(b8.x), bfhi(b8.x), bflo(b8.y), bfhi(b8.y)}; bv[bj][1] = (f32x4){bflo(b8.z), bfhi(b8.z), bflo(b8.w), bfhi(b8.w)}; }
#pragma unroll
        for (int ai = 0; ai < 2; ++ai)
#pragma unroll
            for (int m = 0; m < 4; ++m) { bf16* rowp = base + (size_t)(row0 + ai * HALF + m * 16) * ldc + col0;
#pragma unroll
                for (int bj = 0; bj < 2; ++bj) { f32x4 v0 = acc[ai][bj][m][0] + bv[bj][0], v1 = acc[ai][bj][m][1] + bv[bj][1];
                    u32x4 w; w.x = cvt_pk_bf16(v0[0], v0[1]); w.y = cvt_pk_bf16(v0[2], v0[3]); w.z = cvt_pk_bf16(v1[0], v1[1]); w.w = cvt_pk_bf16(v1[2], v1[3]);
                    st16_wt(rowp + bj * HALF, w); } }
    }
};
struct EpiHid {
    static constexpr bool PERM = true;
    bf16* H;
    __device__ __forceinline__ void operator()(const f32x4 (&acc)[2][2][4][2], const Unit& u, int wr, int wc, int fr, int fq) const {
        const int row0 = u.pm * BM + wr * 64 + fr, col0 = u.pn * 128 + wc * 32 + 8 * fq;
#pragma unroll
        for (int ai = 0; ai < 2; ++ai) { if (ai == 1 && u.half) break;
#pragma unroll
            for (int m = 0; m < 4; ++m) { bf16* rowp = H + (size_t)(row0 + ai * HALF + m * 16) * DFF + col0;
                f32x4 v0, v1;
#pragma unroll
                for (int q = 0; q < 4; ++q) { v0[q] = silu_f(acc[ai][0][m][0][q]) * acc[ai][1][m][0][q]; v1[q] = silu_f(acc[ai][0][m][1][q]) * acc[ai][1][m][1][q]; }
                u32x4 w; w.x = cvt_pk_bf16(v0[0], v0[1]); w.y = cvt_pk_bf16(v0[2], v0[3]); w.z = cvt_pk_bf16(v1[0], v1[1]); w.w = cvt_pk_bf16(v1[2], v1[3]);
                st16_wt(rowp, w); } }
    }
};
struct EpiBf16 {
    static constexpr bool PERM = true;
    bf16* O; int ldc;
    __device__ __forceinline__ void operator()(const f32x4 (&acc)[2][2][4][2], const Unit& u, int wr, int wc, int fr, int fq) const {
        const int row0 = u.pm * BM + wr * 64 + fr, col0 = u.pn * BM + wc * 32 + 8 * fq;
#pragma unroll
        for (int ai = 0; ai < 2; ++ai) { if (ai == 1 && u.half) break;
#pragma unroll
            for (int m = 0; m < 4; ++m) { bf16* rowp = O + (size_t)(row0 + ai * HALF + m * 16) * ldc + col0;
#pragma unroll
                for (int bj = 0; bj < 2; ++bj) { const f32x4 v0 = acc[ai][bj][m][0], v1 = acc[ai][bj][m][1];
                    u32x4 w; w.x = cvt_pk_bf16(v0[0], v0[1]); w.y = cvt_pk_bf16(v0[2], v0[3]); w.z = cvt_pk_bf16(v1[0], v1[1]); w.w = cvt_pk_bf16(v1[2], v1[3]);
                    st16_wt(rowp + bj * HALF, w); } } }
    }
};

template <class Epi, class Sched, bool GATHER, bool ALIGN_EPI>
__device__ __forceinline__ void gemm_phase(LAS unsigned char* lds, const bf16* Aptr, const bf16* Bptr, const int K, const Sched& S, const Epi& E, const int tid) {
    const int wid = __builtin_amdgcn_readfirstlane(tid >> 6), lane = tid & 63, wr = wid >> 2, wc = wid & 3, fr = lane & 15, fq = lane >> 4;
    const int nt = K / BK;
    unsigned voffA[2], voffB[2]; int RA[2], CA[2];
#pragma unroll
    for (int i = 0; i < 2; ++i) { int R, C; stage_rc(tid * 16 + i * 8192, R, C); const int Rb = Epi::PERM ? ((R & ~31) + perm32(R & 31)) : R;
        voffA[i] = (unsigned)(R * K + C) * 2u; voffB[i] = (unsigned)(Rb * K + C) * 2u; RA[i] = R; CA[i] = C; }
    const size_t kstep = (size_t)(BK * 2);
    const size_t hstep = (size_t)HALF * K * 2;
    const unsigned ldsw = (unsigned)wid * 1024u;
    const int aoff = lds_byte(wr * 64 + fr, fq * 8), boff = lds_byte(wc * 32 + fr, fq * 8);
#define PG8_SA(b, h) (((b) * 2 + (h)) * HTB)
#define PG8_SB(b, h) ((4 + (b) * 2 + (h)) * HTB)
#define PG8_GLDS(src, dstoff) __builtin_amdgcn_global_load_lds((const unsigned*)(src), (LAS unsigned*)(lds + (dstoff)), 16, 0, 0)
#define PG8_STAGE_B(bufoff, gbase) do { _Pragma("unroll") for (int _i = 0; _i < 2; ++_i) PG8_GLDS((const char*)(gbase) + voffB[_i], (bufoff) + ldsw + _i * 8192); } while (0)
#define PG8_STAGE_A(bufoff, gbase, h, OFF) do { if constexpr (GATHER) { _Pragma("unroll") for (int _i = 0; _i < 2; ++_i) PG8_GLDS((const char*)(gbase) + OFF[(h) * 2 + _i], (bufoff) + ldsw + _i * 8192); } \
        else { _Pragma("unroll") for (int _i = 0; _i < 2; ++_i) PG8_GLDS((const char*)(gbase) + (h) * hstep + voffA[_i], (bufoff) + ldsw + _i * 8192); } } while (0)
#define PG8_LDA(dst, b, h) do { _Pragma("unroll") for (int m = 0; m < 4; ++m) _Pragma("unroll") for (int k = 0; k < 2; ++k) dst[m][k] = *(const LAS bf16x8*)(lds + PG8_SA(b, h) + aoff + m * 2048 + k * 1024); } while (0)
#define PG8_LDB(dst, b, h) do { _Pragma("unroll") for (int n = 0; n < 2; ++n) _Pragma("unroll") for (int k = 0; k < 2; ++k) dst[n][k] = *(const LAS bf16x8*)(lds + PG8_SB(b, h) + boff + n * 2048 + k * 1024); } while (0)
#define PG8_MMA(ai, bj, At, Bt) do { __builtin_amdgcn_s_setprio(1); _Pragma("unroll") for (int m = 0; m < 4; ++m) _Pragma("unroll") for (int n = 0; n < 2; ++n) _Pragma("unroll") for (int k = 0; k < 2; ++k) \
        acc[ai][bj][m][n] = __builtin_amdgcn_mfma_f32_16x16x32_bf16(Bt[n][k], At[m][k], acc[ai][bj][m][n], 0, 0, 0); __builtin_amdgcn_s_setprio(0); } while (0)
#define PG8_WAIT_V(n) asm volatile("s_waitcnt vmcnt(" #n ")" ::: "memory")
#define PG8_WAIT_L(n) asm volatile("s_waitcnt lgkmcnt(" #n ")" ::: "memory")
#define PG8_BAR __builtin_amdgcn_s_barrier()
#define PG8_SCHED __builtin_amdgcn_sched_barrier(0)
    Unit cur, nxt; int ui = 0;
    if (!S.next(0, cur)) return;
    f32x4 acc[2][2][4][2];
#pragma unroll
    for (int a = 0; a < 2; ++a)
#pragma unroll
        for (int b = 0; b < 2; ++b)
#pragma unroll
            for (int m = 0; m < 4; ++m)
#pragma unroll
                for (int n = 0; n < 2; ++n) acc[a][b][m][n] = (f32x4){0.f, 0.f, 0.f, 0.f};
    bf16x8 At[4][2], B0[2][2], B1[2][2];
    unsigned offA[4] = {0u, 0u, 0u, 0u}, noffA[4] = {0u, 0u, 0u, 0u};
    const char* cA = GATHER ? (const char*)Aptr : (const char*)Aptr + S.a_base(cur, K);
    const char* cB = (const char*)Bptr + S.b_base(cur, K);
    if constexpr (GATHER) { S.a_toks(cur, RA, offA);
        asm volatile("s_waitcnt vmcnt(0)" : "+v"(offA[0]), "+v"(offA[1]), "+v"(offA[2]), "+v"(offA[3]) :: "memory");
        S.a_fin(offA, K, CA, offA); }
#if TS_ENABLE
    unsigned long long tK = 0, tE = 0, tR = 0, tq0 = __builtin_amdgcn_s_memrealtime();
#endif
    if constexpr (Sched::HOOKS) S.a_ready(cur, wid);
#if TS_ENABLE
    { const unsigned long long tq = __builtin_amdgcn_s_memrealtime(); tR += tq - tq0; tq0 = tq; }
#endif
    int pend_pm = -1;
    PG8_STAGE_B(PG8_SB(0, 0), cB); PG8_STAGE_B(PG8_SB(0, 1), cB + hstep); PG8_STAGE_A(PG8_SA(0, 0), cA, 0, offA); PG8_STAGE_A(PG8_SA(0, 1), cA, 1, offA);
    if (wr == 1) PG8_BAR;
    PG8_WAIT_V(2); PG8_BAR;
    PG8_STAGE_B(PG8_SB(1, 0), cB + kstep); PG8_STAGE_A(PG8_SA(1, 0), cA + kstep, 0, offA); PG8_STAGE_B(PG8_SB(1, 1), cB + hstep + kstep);
    PG8_WAIT_V(6); PG8_BAR;
    for (;;) {
        const bool has_next = S.next(ui + 1, nxt);
        const char* nA = cA; const char* nB = cB;
        if (has_next) { nA = GATHER ? (const char*)Aptr : (const char*)Aptr + S.a_base(nxt, K); nB = (const char*)Bptr + S.b_base(nxt, K); }
        if constexpr (GATHER) { if (has_next) S.a_toks(nxt, RA, noffA); else {
#pragma unroll
            for (int q = 0; q < 4; ++q) noffA[q] = offA[q]; } }
        for (int t = 0; t < nt; t += 2) {
            const bool last = (t == nt - 2);
            if (t == 2 && pend_pm >= 0) { S.done(pend_pm, lane); pend_pm = -1; }
            if (last && has_next) {
#if TS_ENABLE
                const unsigned long long ta = __builtin_amdgcn_s_memrealtime();
#endif
                S.a_ready(nxt, wid);
#if TS_ENABLE
                const unsigned long long tb = __builtin_amdgcn_s_memrealtime(); tR += tb - ta; tq0 += tb - ta;
#endif
            }
            const char* a1 = cA + (size_t)(t + 1) * kstep;
            const char* a2 = last ? nA : cA + (size_t)(t + 2) * kstep; const char* b2 = last ? nB : cB + (size_t)(t + 2) * kstep;
            const char* a3 = a2 + kstep; const char* b3 = b2 + kstep;
            if constexpr (GATHER) { if (last && has_next) S.a_fin(noffA, K, CA, noffA); }
            unsigned o2[4];
#pragma unroll
            for (int q = 0; q < 4; ++q) o2[q] = last ? noffA[q] : offA[q];
            PG8_LDB(B0, 0, 0); PG8_LDB(B1, 0, 1); PG8_SCHED; PG8_LDA(At, 0, 0); PG8_STAGE_A(PG8_SA(1, 1), a1, 1, offA);
            PG8_WAIT_V(8); PG8_WAIT_L(0); PG8_BAR; PG8_MMA(0, 0, At, B0); PG8_MMA(0, 1, At, B1); PG8_BAR; PG8_SCHED;
            PG8_LDA(At, 0, 1); PG8_STAGE_B(PG8_SB(0, 0), b2); PG8_STAGE_B(PG8_SB(0, 1), b2 + hstep); PG8_STAGE_A(PG8_SA(0, 0), a2, 0, o2);
            PG8_WAIT_V(8); PG8_WAIT_L(0); PG8_BAR; if (!(Sched::HOOKS && cur.half)) { PG8_MMA(1, 0, At, B0); PG8_MMA(1, 1, At, B1); } PG8_BAR; PG8_SCHED;
            PG8_LDB(B0, 1, 0); PG8_LDB(B1, 1, 1); PG8_SCHED; PG8_LDA(At, 1, 0); PG8_STAGE_A(PG8_SA(0, 1), a2, 1, o2);
            PG8_WAIT_V(8); PG8_WAIT_L(0); PG8_BAR; PG8_MMA(0, 0, At, B0); PG8_MMA(0, 1, At, B1); PG8_BAR; PG8_SCHED;
            PG8_LDA(At, 1, 1); PG8_STAGE_B(PG8_SB(1, 0), b3); PG8_STAGE_B(PG8_SB(1, 1), b3 + hstep); PG8_STAGE_A(PG8_SA(1, 0), a3, 0, o2);
            PG8_WAIT_V(8); PG8_WAIT_L(0); PG8_BAR; if (!(Sched::HOOKS && cur.half)) { PG8_MMA(1, 0, At, B0); PG8_MMA(1, 1, At, B1); } PG8_BAR; PG8_SCHED;
        }
        if constexpr (ALIGN_EPI) { if (wr == 0) PG8_BAR; }
#if TS_ENABLE
        { const unsigned long long tq = __builtin_amdgcn_s_memrealtime(); tK += tq - tq0; tq0 = tq; }
#endif
        E(acc, cur, wr, wc, fr, fq);
#if TS_ENABLE
        { const unsigned long long tq = __builtin_amdgcn_s_memrealtime(); tE += tq - tq0; tq0 = tq; }
#endif
        if constexpr (Sched::HOOKS) pend_pm = cur.pm;
        if (!has_next) break;
#pragma unroll
        for (int a = 0; a < 2; ++a)
#pragma unroll
            for (int b = 0; b < 2; ++b)
#pragma unroll
                for (int m = 0; m < 4; ++m)
#pragma unroll
                    for (int n = 0; n < 2; ++n) acc[a][b][m][n] = (f32x4){0.f, 0.f, 0.f, 0.f};
        cur = nxt; cA = nA; cB = nB; ++ui;
#pragma unroll
        for (int q = 0; q < 4; ++q) offA[q] = noffA[q];
        if constexpr (ALIGN_EPI) { if (wr == 1) PG8_BAR; }
    }
    PG8_WAIT_V(0);
    if constexpr (Sched::HOOKS) { if (pend_pm >= 0) S.done(pend_pm, lane); }
#if TS_ENABLE
    if constexpr (Sched::HOOKS) { if (tid == 0 && S.mode != 0) { unsigned* tsb = S.tsbase; const int o = (S.mode == 1) ? 26 : 29;
        atomicAdd((unsigned long long*)(tsb + 4 * o + 2), tK); atomicAdd((unsigned long long*)(tsb + 4 * (o + 1) + 2), tE); atomicAdd((unsigned long long*)(tsb + 4 * (o + 2) + 2), tR); } }
#endif
    if constexpr (!ALIGN_EPI) { if (wr == 0) PG8_BAR; }
    PG8_BAR;
#undef PG8_SA
#undef PG8_SB
#undef PG8_GLDS
#undef PG8_STAGE_A
#undef PG8_STAGE_B
#undef PG8_LDA
#undef PG8_LDB
#undef PG8_MMA
#undef PG8_WAIT_V
#undef PG8_WAIT_L
#undef PG8_BAR
#undef PG8_SCHED
}
}

struct Args { const float* in[25]; float* out; unsigned char* ws; int ph_lo, ph_hi, pflags, pad; };
enum { I_X = 0, I_C, I_WADA, I_BADA, I_WIN, I_BIN, I_WCM, I_BCM, I_MHG, I_WCR, I_BCR, I_WA, I_BA, I_WX, I_BX, I_LAM, I_LRUG, I_WOUT, I_WR, I_BR, I_WG, I_WU, I_WD, I_LNG, I_LNB };

struct Frame {
    LAS unsigned char* lds;
    int tid, lane, wave, G, bid, zoff, pflags;
    const float* const* in; float* out; unsigned char* ws;
};

__device__ __forceinline__ void transpose_item(const float* W, int ldn, bf16* WT, int ldk, int k0, int n0, int drow0, LAS float* scr, int lane) {
    float tv[64];
    const float* src = W + (size_t)k0 * ldn + n0 + lane;
#pragma unroll
    for (int i = 0; i < 64; ++i) tv[i] = src[(size_t)i * ldn];
#pragma unroll
    for (int i = 0; i < 64; ++i) scr[i * 65 + lane] = tv[i];
    asm volatile("s_waitcnt lgkmcnt(0)" ::: "memory");
    const int c = lane & 7;
#pragma unroll
    for (int j = 0; j < 8; ++j) { const int n = (lane >> 3) + 8 * j; const LAS float* s = scr + (8 * c) * 65 + n;
        u32x4 o; o.x = pk2(s[0 * 65], s[1 * 65]); o.y = pk2(s[2 * 65], s[3 * 65]); o.z = pk2(s[4 * 65], s[5 * 65]); o.w = pk2(s[6 * 65], s[7 * 65]);
        *(u32x4*)(WT + (size_t)(drow0 + n) * ldk + k0 + 8 * c) = o; }
    asm volatile("s_waitcnt lgkmcnt(0)" ::: "memory");
}
__device__ __forceinline__ void conv_dense_item(const Frame& F, int it, LAS float* scr) {
    const int l = it / 2112; int r = it % 2112;
    const float* w_in = F.in[(I_WIN) + F.zoff] + (size_t)l * D * NIN;
    bf16* WIN = (bf16*)(F.ws + WS_WIN) + (size_t)l * NPROJ * D;
    if (r < 1024) { const int kb = r / 64, nb = r % 64; transpose_item(w_in, NIN, WIN, D, kb * 64, nb * 64, nb * 64, scr, F.lane); return; }
    r -= 1024;
    if (r < 512) { const int kb = r / 32, nb = r % 32; transpose_item(w_in + 4112, NIN, WIN, D, kb * 64, nb * 64, 4096 + nb * 64, scr, F.lane); return; }
    r -= 512;
    if (r < 512) { const int kb = r / 16, nb = r % 16; transpose_item(F.in[(I_WOUT) + F.zoff] + (size_t)l * 2048 * 1024, 1024, (bf16*)(F.ws + WS_WOUT) + (size_t)l * 1024 * 2048, 2048, kb * 64, nb * 64, nb * 64, scr, F.lane); return; }
    r -= 512;
    { const int which = r / 32; r %= 32; const int kb = r / 2, nb = r % 2;
      transpose_item(F.in[(which ? I_WX : I_WA) + F.zoff] + (size_t)l * 8 * 128 * 128, 128, (bf16*)(F.ws + WS_WAX) + (size_t)(l * 2 + which) * 128 * 1024, 1024, kb * 64, nb * 64, nb * 64, scr, F.lane); }
}
__device__ __forceinline__ void conv_moe_item(const Frame& F, int l, int it, LAS float* scr) {
    const int e = it / 384; int r = it % 384;
    if (r < 256) { const int which = r / 128; r %= 128; const int kb = r / 8, nb = r % 8, n0 = nb * 64, drow = (n0 / 128) * 256 + which * 128 + (n0 % 128);
        transpose_item(F.in[(which ? I_WU : I_WG) + F.zoff] + (size_t)(l * NE + e) * D * DFF, DFF, (bf16*)(F.ws + WS_WGU) + (size_t)e * 1024 * 1024, 1024, kb * 64, n0, drow, scr, F.lane); return; }
    r -= 256;
    { const int kb = r / 16, nb = r % 16; transpose_item(F.in[(I_WD) + F.zoff] + (size_t)(l * NE + e) * DFF * D, D, (bf16*)(F.ws + WS_WDN) + (size_t)e * 1024 * 512, 512, kb * 64, nb * 64, nb * 64, scr, F.lane); }
}

__device__ __forceinline__ void ln_row(f32x4 (&v)[4]) {
    float s = 0.f;
#pragma unroll
    for (int j = 0; j < 4; ++j) s += (v[j].x + v[j].y) + (v[j].z + v[j].w);
    const float mean = wave_sum(s) * (1.f / D); float s2 = 0.f;
#pragma unroll
    for (int j = 0; j < 4; ++j) { v[j] = v[j] - mean; s2 += (v[j].x * v[j].x + v[j].y * v[j].y) + (v[j].z * v[j].z + v[j].w * v[j].w); }
    const float rstd = __builtin_amdgcn_rsqf(wave_sum(s2) * (1.f / D) + LN_EPS);
#pragma unroll
    for (int j = 0; j < 4; ++j) v[j] = v[j] * rstd;
}
__device__ __forceinline__ float dot2_bf16(unsigned a, unsigned b, float c) {
    typedef __bf16 bf2_t __attribute__((ext_vector_type(2)));
    return __builtin_amdgcn_fdot2_f32_bf16(__builtin_bit_cast(bf2_t, a), __builtin_bit_cast(bf2_t, b), c, false);
}
__device__ __forceinline__ void emit_u(const Frame& F, f32x4 (&v)[4], const LAS float* sh, const LAS float* sc1p, int row, const LAS float* Wif, const float bq) {
    bf16* U_ = (bf16*)(F.ws + WS_U); float* IFG_ = (float*)(F.ws + WS_IFG);
    const int lane = F.lane;
    unsigned up[8];
#pragma unroll
    for (int j = 0; j < 4; ++j) { const f32x4 a = *(const LAS f32x4*)(sc1p + 256 * j + 4 * lane), b = *(const LAS f32x4*)(sh + 256 * j + 4 * lane); v[j] = v[j] * a + b;
        u32x2 w; w.x = pk2(v[j].x, v[j].y); w.y = pk2(v[j].z, v[j].w); *(u32x2*)(U_ + (size_t)row * D + 256 * j + 4 * lane) = w; up[2 * j] = w.x; up[2 * j + 1] = w.y; }
    const LAS unsigned* WL = (const LAS unsigned*)Wif;
    float part[16];
#pragma unroll
    for (int q = 0; q < 16; ++q) { const u32x4 w0 = *(const LAS u32x4*)(WL + ((q * 2 + 0) * 64 + lane) * 4), w1 = *(const LAS u32x4*)(WL + ((q * 2 + 1) * 64 + lane) * 4);
        float p = 0.f;
        p = dot2_bf16(up[0], w0.x, p); p = dot2_bf16(up[1], w0.y, p); p = dot2_bf16(up[2], w0.z, p); p = dot2_bf16(up[3], w0.w, p);
        p = dot2_bf16(up[4], w1.x, p); p = dot2_bf16(up[5], w1.y, p); p = dot2_bf16(up[6], w1.z, p); p = dot2_bf16(up[7], w1.w, p);
        part[q] = p; if ((q & 3) == 3) asm volatile("" ::: "memory"); }
    const float tot = reduce16_scatter(part, lane);
    if ((lane & 15) < 4) { const int q = 8 * (lane >> 5) + 4 * ((lane >> 4) & 1) + (lane & 3); IFG_[(size_t)row * 16 + q] = tot + bq; }
}
__device__ __forceinline__ void load_wif(const Frame& F, int l, LAS float* Wif) {
    const float* w_in = F.in[(I_WIN) + F.zoff] + (size_t)l * D * NIN + 4096;
    LAS bf16* WL = (LAS bf16*)Wif;
    for (int i = F.tid; i < 16 * 1024; i += 512) { const int k = i >> 4, q = i & 15; const int j = k >> 8, ln = (k & 255) >> 2, e4 = k & 3, pi = 2 * j + (e4 >> 1);
        WL[(((q * 2 + (pi >> 2)) * 64 + ln) * 4 + (pi & 3)) * 2 + (e4 & 1)] = (bf16)f2bf(w_in[(size_t)k * NIN + q]); }
}

__device__ __forceinline__ int build_tile_table(const Frame& F, int l) {
    LAS int* tt = (LAS int*)(F.lds + LDS_TT);
    const unsigned* cnt = (const unsigned*)(F.ws + WS_CTL) + CW_CNT + l * 2048;
    __syncthreads();
    if (F.wave == 0) {
        const int lane = F.lane, e = lane & 31; const bool act = lane < 32;
        const int c = act ? (int)cnt[64 * e] : 0;
        const int n = (c + 255) >> 8, lastrows = c - ((n - 1) << 8);
        const int nbig = act ? ((n > 0 && lastrows <= 128) ? n - 1 : n) : 0;
        const int hs = (act && n > nbig) ? 1 : 0;
        const int ib = (int)wave_scan_sum((float)nbig, lane), is = (int)wave_scan_sum((float)hs, lane);
        const int total_big = (int)rdlane((float)ib, 63), total_small = (int)rdlane((float)is, 63);
        const int base = ib - nbig, sidx = total_big + is - hs;
        if (act) { tt[e] = c; tt[32 + e] = base; tt[225 + e] = nbig; tt[257 + e] = sidx;
            for (int j = 0; j < nbig; ++j) tt[65 + base + j] = (e << 16) | j;
            if (hs) tt[65 + sidx] = (e << 16) | (1 << 15) | (n - 1); }
        if (lane == 0) tt[64] = total_big + total_small;
    }
    __syncthreads();
    return tt[64];
}


#define Ub    ((bf16*)(ws + WS_U))
#define QKpre ((bf16*)(ws + WS_A))
#define Yb    ((bf16*)(ws + WS_A))
#define Vb    ((bf16*)(ws + WS_V))
#define Ob    ((bf16*)(ws + WS_O))
#define XRb   ((bf16*)(ws + WS_XR))
#define GRb   ((bf16*)(ws + WS_GR))
#define Qb    ((bf16*)(ws + WS_B))
#define Kb    ((bf16*)(ws + WS_B) + (size_t)S * D)
#define YO    ((bf16*)(ws + WS_B))
#define XB    ((bf16*)(ws + WS_XB))
#define UC    ((bf16*)(ws + WS_UC))
#define HLOC  ((bf16*)(ws + WS_HLOC))
#define PCUM  ((bf16*)(ws + WS_PCUM))
#define IFG   ((float*)(ws + WS_IFG))
#define BCUM  ((float*)(ws + WS_BCUM))
#define CHS   ((float*)(ws + WS_CHS))
#define MST   ((float*)(ws + WS_MST))
#define NLOC  ((float*)(ws + WS_NLOC))
#define NST   ((float*)(ws + WS_NST))
#define AC    ((float*)(ws + WS_AC))
#define HC    ((float*)(ws + WS_HC))
#define TOKE  ((int*)(ws + WS_TOKE))
#define TOKP  ((int*)(ws + WS_TOKP))
#define TOKG  ((float*)(ws + WS_TOKG))
#define TLIST ((int*)(ws + WS_TLIST))
#define HID   ((bf16*)(ws + WS_HID))
#define YB    ((bf16*)(ws + WS_YB))
#define ADA   ((float*)(ws + WS_ADA))
#define ada   (ADA + l * 6144)
#define ECNT  ((unsigned*)(ws + WS_CTL) + CW_CNT + l * 2048)
#define PH_BEGIN() int zoff; asm volatile("s_mov_b32 %0, 0" : "=s"(zoff)); unsigned char* ws = args.ws + zoff; F.zoff = zoff; F.ws = ws; \
    int tid = threadIdx.x; asm volatile("" : "+v"(tid)); const int lane = tid & 63; const int wave = __builtin_amdgcn_readfirstlane(tid >> 6); \
    int G = gridDim.x; asm volatile("" : "+s"(G)); int bid = blockIdx.x; asm volatile("" : "+s"(bid)); \
    F.tid = tid; F.lane = lane; F.wave = wave; F.G = G; F.bid = bid; const int gw = bid * 8 + wave, NGW = G * 8; (void)gw; (void)NGW; (void)lane

typedef short s16x4 __attribute__((ext_vector_type(4)));
__device__ __forceinline__ bf16x8 tr_read2(const LAS bf16* p0, const LAS bf16* p1) {
    const s16x4 a = __builtin_amdgcn_ds_read_tr16_b64_v4i16((LAS s16x4*)p0), b = __builtin_amdgcn_ds_read_tr16_b64_v4i16((LAS s16x4*)p1);
    bf16x8 r; r[0] = a[0]; r[1] = a[1]; r[2] = a[2]; r[3] = a[3]; r[4] = b[0]; r[5] = b[1]; r[6] = b[2]; r[7] = b[3]; return r;
}
__device__ __forceinline__ f32x4 mfma16(bf16x8 a, bf16x8 b, f32x4 c) { return __builtin_amdgcn_mfma_f32_16x16x32_bf16(a, b, c, 0, 0, 0); }

__device__ __forceinline__ void phaseE_all(const Frame& F, unsigned char* ws, const int l) {
    const int tid = F.tid, lane = F.lane, wave = F.wave, zoff = F.zoff, G = F.G, bid = F.bid;
    constexpr int EP = 136;
    LAS bf16* Ks = (LAS bf16*)(F.lds); LAS bf16* Vs = (LAS bf16*)(F.lds + 34816); LAS bf16* Cs = (LAS bf16*)(F.lds + 69632);
    LAS float* wsv = (LAS float*)(F.lds + 108800); LAS float* Mt = wsv + 128; LAS float* bt = wsv + 256;
    LAS float* cwq = (LAS float*)(F.lds + 110336);
    u32x4 kt[4], vt[4], ct[4]; float nstv = 0.f, sb0 = 0.f, sb1 = 0.f, si0 = 0.f, si1 = 0.f, smp = 0.f;
#define E_LOAD(UNIT) do { const int c_ = (UNIT) >> 3, h_ = (UNIT) & 7; \
        _Pragma("unroll") for (int it = 0; it < 4; ++it) { const int i = tid + it * 512, r = i >> 4, cg = i & 15; const size_t gofs = ((size_t)c_ * CH + r) * D + h_ * 128 + cg * 8; \
            kt[it] = *(const u32x4*)(Kb + gofs); vt[it] = *(const u32x4*)(Vb + gofs); ct[it] = *(const u32x4*)(UC + (size_t)(c_ * 8 + h_) * 16384 + (size_t)i * 8); } \
        if (tid < 128) nstv = NST[(c_ * 8 + h_) * 128 + tid]; \
        if (wave == 1) { const size_t s0_ = (size_t)c_ * CH + 2 * lane; sb0 = BCUM[s0_ * 8 + h_]; sb1 = BCUM[(s0_ + 1) * 8 + h_]; si0 = IFG[s0_ * 16 + h_]; si1 = IFG[(s0_ + 1) * 16 + h_]; smp = MST[c_ * 8 + h_]; } } while (0)
    int hcur = -1;
    int unit = bid;
    u32x4 qraw[4][4];
#define E_QLOAD(UNIT) do { const int c_ = (UNIT) >> 3, h_ = (UNIT) & 7; const int tq = 16 * wave + (lane & 15); \
        _Pragma("unroll") for (int ks = 0; ks < 4; ++ks) _Pragma("unroll") for (int k = 0; k < 4; ++k) { const int srow = c_ * CH + tq - 3 + k; qraw[ks][k] = (u32x4){0u, 0u, 0u, 0u}; \
            if (srow >= 0) qraw[ks][k] = *(const u32x4*)(QKpre + (size_t)srow * 2048 + h_ * 128 + 32 * ks + 8 * (lane >> 4)); } } while (0)
    if (unit < NC * 8) { E_LOAD(unit); E_QLOAD(unit); }
#pragma unroll 1
    for (; unit < NC * 8; unit += G) {
        int tl_ = tid; asm volatile("" : "+v"(tl_));
        const int tid = tl_, lane = tl_ & 63;
        const int c = unit >> 3, h = unit & 7;
        if (h != hcur) { lds_barrier();
            for (int i = tid; i < 640; i += 512) { const int k5 = i >> 7, col = i & 127; cwq[i] = (k5 < 4) ? F.in[(I_WCM) + zoff][(size_t)l * 4 * 2048 + k5 * 2048 + h * 128 + col] : F.in[(I_BCM) + zoff][(size_t)l * 2048 + h * 128 + col]; }
            if (tid < 128) cwq[768 + tid] = F.in[(I_MHG) + zoff][l * 1024 + h * 128 + tid];
            hcur = h; }
#pragma unroll
        for (int it = 0; it < 4; ++it) { const int i = tid + it * 512, r = i >> 4, cg = i & 15;
            *(LAS u32x4*)(Ks + r * EP + cg * 8) = kt[it]; *(LAS u32x4*)(Vs + r * EP + cg * 8) = vt[it];
            { const u32x4 cv = ct[it];
              const int pos = i * 2, L = pos & 63, wv = (pos >> 6) & 7, et = pos >> 9, gg = L >> 4, ll = L & 15;
              u32x2 c0; c0.x = cv.x; c0.y = cv.y; u32x2 c1; c1.x = cv.z; c1.y = cv.w;
              *(LAS u32x2*)(Cs + (16 * et + ll) * EP + 16 * wv + 4 * gg) = c0; *(LAS u32x2*)(Cs + (16 * et + ll + 1) * EP + 16 * wv + 4 * gg) = c1; } }
        if (tid < 128) { const unsigned hi = f2bf(nstv); Cs[128 * EP + tid] = (bf16)hi; Cs[129 * EP + tid] = (bf16)f2bf(nstv - bf2f(hi)); }
        float mprev_u = 0.f;
        if (wave == 1) {
            const int t0 = 2 * lane;
            const float w0 = si0 - sb0, w1 = si1 - sb1;
            const float pm = fmaxf(w0, w1); const float incl = wave_scan_max(pm, lane);
            float excl = __shfl_up(incl, 1); if (lane == 0) excl = -3.0e38f;
            wsv[t0] = w0; wsv[t0 + 1] = w1; bt[t0] = sb0; bt[t0 + 1] = sb1;
            Mt[t0] = fmaxf(fmaxf(excl, w0), smp); Mt[t0 + 1] = fmaxf(incl, smp);
            if (lane == 0) cwq[640] = smp;
        }
        (void)mprev_u;
        lds_barrier();
        u32x2 ogate[8];
        { const int t_ = 16 * wave + (lane & 15), g_ = lane >> 4;
#pragma unroll
          for (int et = 0; et < 8; ++et) ogate[et] = *(const u32x2*)(Ob + ((size_t)c * CH + t_) * D + h * 128 + 16 * et + 4 * g_); }
        if (unit + G < NC * 8) E_LOAD(unit + G);
        {
            const int g = lane >> 4, li = lane & 15, t = 16 * wave + li;
            bf16x8 qf[4];
    #pragma unroll
            for (int ks = 0; ks < 4; ++ks) {
                u32x4 raw[4];
    #pragma unroll
                for (int k = 0; k < 4; ++k) raw[k] = qraw[ks][k];
                float y[8];
                { const f32x4 b0 = *(const LAS f32x4*)(cwq + 4 * 128 + 32 * ks + 8 * g), b1 = *(const LAS f32x4*)(cwq + 4 * 128 + 32 * ks + 8 * g + 4);
                  y[0] = b0.x; y[1] = b0.y; y[2] = b0.z; y[3] = b0.w; y[4] = b1.x; y[5] = b1.y; y[6] = b1.z; y[7] = b1.w; }
    #pragma unroll
                for (int k = 0; k < 4; ++k) { const f32x4 w0 = *(const LAS f32x4*)(cwq + k * 128 + 32 * ks + 8 * g), w1 = *(const LAS f32x4*)(cwq + k * 128 + 32 * ks + 8 * g + 4);
                    y[0] += w0.x * bflo(raw[k].x); y[1] += w0.y * bfhi(raw[k].x); y[2] += w0.z * bflo(raw[k].y); y[3] += w0.w * bfhi(raw[k].y);
                    y[4] += w1.x * bflo(raw[k].z); y[5] += w1.y * bfhi(raw[k].z); y[6] += w1.z * bflo(raw[k].w); y[7] += w1.w * bfhi(raw[k].w); }
                u32x4 pq; pq.x = pk2(silu_f(y[0]), silu_f(y[1])); pq.y = pk2(silu_f(y[2]), silu_f(y[3])); pq.z = pk2(silu_f(y[4]), silu_f(y[5])); pq.w = pk2(silu_f(y[6]), silu_f(y[7]));
                qf[ks] = __builtin_bit_cast(bf16x8, pq);
            }
            const float Mtt = Mt[t]; float dsum = 0.f;
            unsigned pk[8][2];
    #pragma unroll
            for (int st = 0; st < 8; ++st) {
                pk[st][0] = 0u; pk[st][1] = 0u;
                if (st <= wave) {
                    f32x4 sa = {0.f, 0.f, 0.f, 0.f};
    #pragma unroll
                    for (int ks = 0; ks < 4; ++ks) sa = mfma16(*(const LAS bf16x8*)(Ks + (16 * st + li) * EP + 32 * ks + 8 * g), qf[ks], sa);
                    const f32x4 w4 = *(const LAS f32x4*)(wsv + 16 * st + 4 * g);
                    float v[4];
    #pragma unroll
                    for (int r = 0; r < 4; ++r) { const int s = 16 * st + 4 * g + r; v[r] = (s <= t) ? sa[r] * __expf(w4[r] - Mtt) : 0.f; dsum += v[r]; }
                    pk[st][0] = pk2(v[0], v[1]); pk[st][1] = pk2(v[2], v[3]);
                }
            }
            dsum = xrow_sum(dsum);
            f32x4 nacc[8];
    #pragma unroll
            for (int et = 0; et < 8; ++et) nacc[et] = (f32x4){0.f, 0.f, 0.f, 0.f};
            const int rsub = li >> 2, csub = 4 * (li & 3);
    #pragma unroll
            for (int kp = 0; kp < 4; ++kp) {
                if (2 * kp <= wave) {
                    u32x4 pw = {pk[2 * kp][0], pk[2 * kp][1], pk[2 * kp + 1][0], pk[2 * kp + 1][1]};
                    const bf16x8 pf = __builtin_bit_cast(bf16x8, pw);
    #pragma unroll
                    for (int et = 0; et < 8; ++et) { const bf16x8 vf = tr_read2(Vs + (32 * kp + 4 * g + rsub) * EP + 16 * et + csub, Vs + (32 * kp + 16 + 4 * g + rsub) * EP + 16 * et + csub); nacc[et] = mfma16(vf, pf, nacc[et]); }
                }
            }
            f32x4 iacc[9];
    #pragma unroll
            for (int et = 0; et < 9; ++et) { f32x4 a = {0.f, 0.f, 0.f, 0.f};
    #pragma unroll
                for (int ks = 0; ks < 4; ++ks) a = mfma16(*(const LAS bf16x8*)(Cs + (16 * et + li) * EP + 32 * ks + 8 * g), qf[ks], a);
                iacc[et] = a; }
            float dint = iacc[8][0] + iacc[8][1]; dint = __shfl(dint, li);
            const float winter = __expf(cwq[640] - Mtt);
            const float den = dsum + winter * dint;
            const float dn = fmaxf(fabsf(den), __expf(-(bt[t] + Mtt)));
            const float inv = 1.f / dn;
            float sm = 0.f;
    #pragma unroll
            for (int et = 0; et < 8; ++et) { nacc[et] = (nacc[et] + iacc[et] * winter) * inv; sm += (nacc[et][0] + nacc[et][1]) + (nacc[et][2] + nacc[et][3]); }
            sm = xrow_sum(sm);
            const float mean = sm * (1.f / 128.f); float s2 = 0.f;
    #pragma unroll
            for (int et = 0; et < 8; ++et) { nacc[et] = nacc[et] - mean; s2 += (nacc[et][0] * nacc[et][0] + nacc[et][1] * nacc[et][1]) + (nacc[et][2] * nacc[et][2] + nacc[et][3] * nacc[et][3]); }
            s2 = xrow_sum(s2);
            const float rstd = __builtin_amdgcn_rsqf(s2 * (1.f / 128.f) + LN_EPS);
            asm volatile("" ::: "memory");
            if (unit + G < NC * 8) E_QLOAD(unit + G);
            const size_t srow = (size_t)c * CH + t; const LAS float* mg = cwq + 768 + 4 * g;
    #pragma unroll
            for (int et = 0; et < 8; ++et) { const u32x2 o2 = ogate[et]; const f32x4 gm = *(const LAS f32x4*)(mg + 16 * et);
                u32x2 w; w.x = pk2(nacc[et][0] * rstd * sigmoid_f(bflo(o2.x)) * gm.x, nacc[et][1] * rstd * sigmoid_f(bfhi(o2.x)) * gm.y); w.y = pk2(nacc[et][2] * rstd * sigmoid_f(bflo(o2.y)) * gm.z, nacc[et][3] * rstd * sigmoid_f(bfhi(o2.y)) * gm.w);
                *(u32x2*)(Yb + srow * 2048 + h * 128 + 16 * et + 4 * g) = w; }
        }

        lds_barrier();
    }
#undef E_LOAD
#undef E_QLOAD
}

__device__ __forceinline__ void phaseC_mlstm_all(const Frame& F, unsigned char* ws, const int l) {
    const int tid = F.tid, lane = F.lane, wave = F.wave, zoff = F.zoff, G = F.G, bid = F.bid;
    constexpr int KP = 136, VP = 152;
    LAS bf16* Ks = (LAS bf16*)(F.lds); LAS bf16* Vs = (LAS bf16*)(F.lds + 34816); LAS float* wgt = (LAS float*)(F.lds + 73728);
    LAS float* cw = (LAS float*)(F.lds + 74240);
    const int cg = tid & 15, rq = tid >> 4;
    u32x4 rk_[7], rv_[4]; float gi0 = 0.f, gi1 = 0.f, gf0 = 0.f, gf1 = 0.f;
    int hcur = -1;
#define C_LOAD(UNIT) do { const int c_ = (UNIT) >> 3, h_ = (UNIT) & 7; \
        _Pragma("unroll") for (int i = 0; i < 7; ++i) { const int s_ = c_ * CH + rq * 4 - 3 + i; rk_[i] = (u32x4){0u, 0u, 0u, 0u}; \
            if (s_ >= 0) rk_[i] = *(const u32x4*)(QKpre + (size_t)s_ * 2048 + 1024 + h_ * 128 + cg * 8); } \
        _Pragma("unroll") for (int rr = 0; rr < 4; ++rr) rv_[rr] = *(const u32x4*)(Vb + ((size_t)c_ * CH + rq * 4 + rr) * D + h_ * 128 + cg * 8); \
        if (wave == 0) { const size_t s0_ = (size_t)c_ * CH + 2 * lane; gi0 = IFG[s0_ * 16 + h_]; gi1 = IFG[(s0_ + 1) * 16 + h_]; gf0 = IFG[s0_ * 16 + 8 + h_]; gf1 = IFG[(s0_ + 1) * 16 + 8 + h_]; } } while (0)
    int unit = bid;
    if (unit < NC * 8) C_LOAD(unit);
#pragma unroll 1
    for (; unit < NC * 8; unit += G) {
        const int c = unit >> 3, h = unit & 7;
        if (h != hcur) {
            lds_barrier();
            for (int i = tid; i < 640; i += 512) { const int k5 = i >> 7, col = i & 127;
                cw[i] = (k5 < 4) ? F.in[(I_WCM) + zoff][(size_t)l * 4 * 2048 + k5 * 2048 + 1024 + h * 128 + col] : F.in[(I_BCM) + zoff][(size_t)l * 2048 + 1024 + h * 128 + col]; }
            hcur = h; lds_barrier();
        }
        if (wave == 0) {
            const int t0 = 2 * lane; const size_t s0 = (size_t)c * CH + t0;
            const float l0 = logsigmoid_f(gf0), l1 = logsigmoid_f(gf1);
            const float pair = l0 + l1; const float incl = wave_scan_sum(pair, lane);
            const float b0 = incl - pair + l0, b1 = incl;
            const float blast = rdlane(incl, 63);
            const float g0 = blast - b0 + gi0, g1 = blast - b1 + gi1;
            const float a = wave_max(fmaxf(g0, g1));
            wgt[t0] = __expf(g0 - a); wgt[t0 + 1] = __expf(g1 - a);
            BCUM[s0 * 8 + h] = b0; BCUM[(s0 + 1) * 8 + h] = b1;
            if (lane == 0) { CHS[(c * 8 + h) * 2] = blast; CHS[(c * 8 + h) * 2 + 1] = a; }
        }
        {
            float w[5][8];
#pragma unroll
            for (int k = 0; k < 5; ++k) { const f32x4 a = *(const LAS f32x4*)(cw + k * 128 + cg * 8), b = *(const LAS f32x4*)(cw + k * 128 + cg * 8 + 4);
                w[k][0] = a.x; w[k][1] = a.y; w[k][2] = a.z; w[k][3] = a.w; w[k][4] = b.x; w[k][5] = b.y; w[k][6] = b.z; w[k][7] = b.w; }
            float xv[7][8];
#pragma unroll
            for (int i = 0; i < 7; ++i) { const u32x4 raw = rk_[i];
                xv[i][0] = bflo(raw.x); xv[i][1] = bfhi(raw.x); xv[i][2] = bflo(raw.y); xv[i][3] = bfhi(raw.y); xv[i][4] = bflo(raw.z); xv[i][5] = bfhi(raw.z); xv[i][6] = bflo(raw.w); xv[i][7] = bfhi(raw.w); }
#pragma unroll
            for (int rr = 0; rr < 4; ++rr) { float y[8];
#pragma unroll
                for (int j = 0; j < 8; ++j) { float a = w[4][j];
#pragma unroll
                    for (int k = 0; k < 4; ++k) a += w[k][j] * xv[rr + k][j];
                    y[j] = silu_f(a) * 0.08838834764831845f; }
                u32x4 o; o.x = pk2(y[0], y[1]); o.y = pk2(y[2], y[3]); o.z = pk2(y[4], y[5]); o.w = pk2(y[6], y[7]);
                const size_t srow = (size_t)c * CH + rq * 4 + rr;
                *(u32x4*)(Kb + srow * D + h * 128 + cg * 8) = o;
                *(LAS u32x4*)(Ks + (rq * 4 + rr) * KP + cg * 8) = o;
            }
        }
        u32x4 vcur[4];
#pragma unroll
        for (int rr = 0; rr < 4; ++rr) vcur[rr] = rv_[rr];
        lds_barrier();
        if (unit + G < NC * 8) C_LOAD(unit + G);
#pragma unroll
        for (int rr = 0; rr < 4; ++rr) { const int r = rq * 4 + rr; const u32x4 raw = vcur[rr]; const float wg = wgt[r];
            u32x4 o; o.x = pk2(bflo(raw.x) * wg, bfhi(raw.x) * wg); o.y = pk2(bflo(raw.y) * wg, bfhi(raw.y) * wg); o.z = pk2(bflo(raw.z) * wg, bfhi(raw.z) * wg); o.w = pk2(bflo(raw.w) * wg, bfhi(raw.w) * wg);
            *(LAS u32x4*)(Vs + r * VP + cg * 8) = o;
            if (cg == 0) { u32x4 e0 = {f2bf(wg), 0u, 0u, 0u}, e1 = {0u, 0u, 0u, 0u}; *(LAS u32x4*)(Vs + r * VP + 128) = e0; *(LAS u32x4*)(Vs + r * VP + 136) = e1; } }
        lds_barrier();
        {
            const int g = lane >> 4, li = lane & 15, rsub = li >> 2, csub = 4 * (li & 3);
            bf16x8 af[4];
#pragma unroll
            for (int ks = 0; ks < 4; ++ks) af[ks] = tr_read2(Ks + (32 * ks + 8 * g + rsub) * KP + 16 * wave + csub, Ks + (32 * ks + 8 * g + 4 + rsub) * KP + 16 * wave + csub);
#pragma unroll
            for (int et = 0; et < 9; ++et) {
                f32x4 acc = {0.f, 0.f, 0.f, 0.f};
#pragma unroll
                for (int ks = 0; ks < 4; ++ks) { const bf16x8 bfr = tr_read2(Vs + (32 * ks + 8 * g + rsub) * VP + 16 * et + csub, Vs + (32 * ks + 8 * g + 4 + rsub) * VP + 16 * et + csub); acc = mfma16(af[ks], bfr, acc); }
                if (et < 8) { u32x2 o; o.x = pk2(acc[0], acc[1]); o.y = pk2(acc[2], acc[3]); *(u32x2*)(UC + (size_t)(c * 8 + h) * 16384 + ((et * 8 + wave) * 64 + lane) * 4) = o; }
                else if (li == 0) *(f32x4*)(NLOC + (c * 8 + h) * 128 + 16 * wave + 4 * g) = acc;
            }
        }
        lds_barrier();
    }
#undef C_LOAD
}

__device__ __forceinline__ void bcast4(float x, float& t0, float& t1, float& t2, float& t3) {
    const unsigned u = __float_as_uint(x);
    const auto s = __builtin_amdgcn_permlane16_swap(u, u, false, false);
    const auto a = __builtin_amdgcn_permlane32_swap(s[0], s[0], false, false);
    const auto b = __builtin_amdgcn_permlane32_swap(s[1], s[1], false, false);
    t0 = __uint_as_float(a[0]); t2 = __uint_as_float(a[1]); t1 = __uint_as_float(b[0]); t3 = __uint_as_float(b[1]);
}

__device__ __forceinline__ void phaseC_lru_all(const Frame& F, unsigned char* ws, const int l) {
    const int tid = F.tid, lane = F.lane, wave = F.wave, zoff = F.zoff, G = F.G, bid = F.bid;
    constexpr int XP = 136;
    LAS bf16* Xc = (LAS bf16*)(F.lds); LAS bf16* Hst = (LAS bf16*)(F.lds + 34816); LAS bf16* Pst = (LAS bf16*)(F.lds + 69632); LAS float* cwr = (LAS float*)(F.lds + 104448);
    const int cg = tid & 15, rq = tid >> 4, g = lane >> 4, li = lane & 15;
    u32x4 rx_[7];
    bf16x8 wa[4], wx[4]; float ba = 0.f, bx = 0.f, sp = 0.f;
    int ncur = -1;
#define L_LOAD(UNIT) do { const int c_ = (UNIT) >> 3, n_ = (UNIT) & 7; \
        _Pragma("unroll") for (int i = 0; i < 7; ++i) { const int s_ = c_ * CH + rq * 4 - 3 + i; rx_[i] = (u32x4){0u, 0u, 0u, 0u}; if (s_ >= 0) rx_[i] = *(const u32x4*)(XRb + (size_t)s_ * D + n_ * 128 + cg * 8); } } while (0)
    int unit = bid;
#if TS_ENABLE
    unsigned long long ta_ = 0, tb_ = 0, tc_ = 0, td_ = 0;
#endif
    if (unit < NC * 8) L_LOAD(unit);
#pragma unroll 1
    for (; unit < NC * 8; unit += G) {
        const int c = unit >> 3, n = unit & 7;
#if TS_ENABLE
        const unsigned long long t0_ = __builtin_amdgcn_s_memrealtime();
#endif
        if (n != ncur) {
            lds_barrier();
            for (int i = tid; i < 640; i += 512) { const int k5 = i >> 7, col = i & 127; cwr[i] = (k5 < 4) ? F.in[(I_WCR) + zoff][(size_t)l * 4 * 1024 + k5 * 1024 + n * 128 + col] : F.in[(I_BCR) + zoff][(size_t)l * 1024 + n * 128 + col]; }
            const bf16* wax = (const bf16*)(ws + WS_WAX) + (size_t)(l * 2) * 128 * 1024 + (size_t)(16 * wave + li) * 1024 + n * 128 + 8 * g;
#pragma unroll
            for (int ks = 0; ks < 4; ++ks) { wa[ks] = *(const bf16x8*)(wax + 32 * ks); wx[ks] = *(const bf16x8*)(wax + (size_t)128 * 1024 + 32 * ks); }
            const int ch = n * 128 + 16 * wave + li;
            ba = F.in[(I_BA) + zoff][l * 1024 + ch]; bx = F.in[(I_BX) + zoff][l * 1024 + ch]; sp = softplus_f(-F.in[(I_LAM) + zoff][l * 1024 + ch]);
            ncur = n; lds_barrier();
        }
        {
            float w[5][8];
#pragma unroll
            for (int k = 0; k < 5; ++k) { const f32x4 a = *(const LAS f32x4*)(cwr + k * 128 + cg * 8), b = *(const LAS f32x4*)(cwr + k * 128 + cg * 8 + 4);
                w[k][0] = a.x; w[k][1] = a.y; w[k][2] = a.z; w[k][3] = a.w; w[k][4] = b.x; w[k][5] = b.y; w[k][6] = b.z; w[k][7] = b.w; }
            float xv[7][8];
#pragma unroll
            for (int i = 0; i < 7; ++i) { const u32x4 raw = rx_[i];
                xv[i][0] = bflo(raw.x); xv[i][1] = bfhi(raw.x); xv[i][2] = bflo(raw.y); xv[i][3] = bfhi(raw.y); xv[i][4] = bflo(raw.z); xv[i][5] = bfhi(raw.z); xv[i][6] = bflo(raw.w); xv[i][7] = bfhi(raw.w); }
#pragma unroll
            for (int rr = 0; rr < 4; ++rr) { float y[8];
#pragma unroll
                for (int j = 0; j < 8; ++j) { float a = w[4][j];
#pragma unroll
                    for (int k = 0; k < 4; ++k) a += w[k][j] * xv[rr + k][j];
                    y[j] = a; }
                u32x4 o; o.x = pk2(y[0], y[1]); o.y = pk2(y[2], y[3]); o.z = pk2(y[4], y[5]); o.w = pk2(y[6], y[7]);
                *(LAS u32x4*)(Xc + (rq * 4 + rr) * XP + cg * 8) = o; }
        }
        lds_barrier();
#if TS_ENABLE
        const unsigned long long t1_ = __builtin_amdgcn_s_memrealtime(); ta_ += t1_ - t0_;
#endif
        if (unit + G < NC * 8) L_LOAD(unit + G);
        f32x4 aA[8], aX[8];
#pragma unroll
        for (int tile = 0; tile < 8; ++tile) {
            f32x4 a0 = {0.f, 0.f, 0.f, 0.f}, a1 = {0.f, 0.f, 0.f, 0.f};
#pragma unroll
            for (int ks = 0; ks < 4; ++ks) { const bf16x8 af = *(const LAS bf16x8*)(Xc + (16 * tile + li) * XP + 32 * ks + 8 * g); a0 = mfma16(af, wa[ks], a0); a1 = mfma16(af, wx[ks], a1); }
            aA[tile] = a0; aX[tile] = a1;
        }
#if TS_ENABLE
        asm volatile("" :: "v"(aA[7]), "v"(aX[7])); const unsigned long long t2_ = __builtin_amdgcn_s_memrealtime(); tb_ += t2_ - t1_;
#endif
        float cP = 1.f, cH = 0.f;
        if (!(F.pflags & 128)) {
#pragma unroll
        for (int tile = 0; tile < 8; ++tile) {
            float hh = 0.f, pp = 1.f; float Pl[4], Hl[4];
#pragma unroll
            for (int r = 0; r < 4; ++r) {
                const float xcv = bf2f(Xc[(16 * tile + 4 * g + r) * XP + 16 * wave + li]);
                const float rgate = sigmoid_f(aA[tile][r] + ba), ig = sigmoid_f(aX[tile][r] + bx);
                const float la = -8.0f * rgate * sp; const float a = fast_exp(la);
                const float xin = __builtin_amdgcn_sqrtf(1.0f - a * a) * (ig * xcv);
                hh = a * hh + xin; pp = pp * a; Pl[r] = pp; Hl[r] = hh;
            }
            float p0, p1, p2, p3, h0, h1, h2, h3;
            bcast4(pp, p0, p1, p2, p3); bcast4(hh, h0, h1, h2, h3);
            float eP = cP, eH = cH;
            if (g > 0) { eH = p0 * eH + h0; eP = eP * p0; }
            if (g > 1) { eH = p1 * eH + h1; eP = eP * p1; }
            if (g > 2) { eH = p2 * eH + h2; eP = eP * p2; }
            if (!(F.pflags & 64)) {
#pragma unroll
            for (int r = 0; r < 4; ++r) { const int sl = 16 * tile + 4 * g + r;
                Hst[sl * XP + 16 * wave + li] = (bf16)f2bf(Hl[r] + Pl[r] * eH); Pst[sl * XP + 16 * wave + li] = (bf16)f2bf(Pl[r] * eP); }
            }
            cH = p0 * cH + h0; cP = cP * p0; cH = p1 * cH + h1; cP = cP * p1; cH = p2 * cH + h2; cP = cP * p2; cH = p3 * cH + h3; cP = cP * p3;
        }
        }
        if (g == 0) { AC[c * 1024 + n * 128 + 16 * wave + li] = cP; HC[c * 1024 + n * 128 + 16 * wave + li] = cH; }
#if TS_ENABLE
        const unsigned long long t3_ = __builtin_amdgcn_s_memrealtime(); tc_ += t3_ - t2_;
#endif
        lds_barrier();
        if (!(F.pflags & 64)) {
#pragma unroll
        for (int it = 0; it < 4; ++it) { const int i = tid + it * 512, row = i >> 4, c8 = i & 15; const size_t gofs = ((size_t)c * CH + row) * D + n * 128 + c8 * 8;
            *(u32x4*)(HLOC + gofs) = *(const LAS u32x4*)(Hst + row * XP + c8 * 8); *(u32x4*)(PCUM + gofs) = *(const LAS u32x4*)(Pst + row * XP + c8 * 8); }
        }
#if TS_ENABLE
        td_ += __builtin_amdgcn_s_memrealtime() - t3_;
#endif
    }
#if TS_ENABLE
    if (tid == 0 && l == 1) { unsigned* tsb = (unsigned*)(ws + WS_CTL) + CW_TS; atomicAdd((unsigned long long*)(tsb + 4 * 36 + 2), ta_); atomicAdd((unsigned long long*)(tsb + 4 * 37 + 2), tb_); atomicAdd((unsigned long long*)(tsb + 4 * 38 + 2), tc_); atomicAdd((unsigned long long*)(tsb + 4 * 39 + 2), td_); }
#endif
    lds_barrier();
#undef L_LOAD
}

static __device__ __forceinline__ void run_gemm_proj(LAS unsigned char* lds, unsigned char* ws, const float* bias, int l, int G, int bid, int tid) {
    pg8::DenseOrder So; So.init(S, NPROJ, G, bid);
    LAS bf16* lb = (LAS bf16*)(lds + pg8::STAGE_BYTES);
    for (int i = tid; i < NIN; i += 512) lb[i] = (bf16)f2bf(bias[i]);
    __syncthreads();
    pg8::EpiProj E{QKpre, Vb, Ob, XRb, GRb, lb};
    pg8::gemm_phase<pg8::EpiProj, pg8::DenseOrder, false, true>(lds, Ub, (const bf16*)(ws + WS_WIN) + (size_t)l * NPROJ * D, D, So, E, tid);
}
static __device__ __forceinline__ void run_gemm_out(LAS unsigned char* lds, unsigned char* ws, int l, int G, int bid, int tid) {
    pg8::DenseOrder So; So.init(S, D, G, bid);
    pg8::EpiBf16 E{YO, D};
    pg8::gemm_phase<pg8::EpiBf16, pg8::DenseOrder, false, false>(lds, Yb, (const bf16*)(ws + WS_WOUT) + (size_t)l * 1024 * 2048, 2048, So, E, tid);
}
static __device__ __forceinline__ void run_gemm_gu(LAS unsigned char* lds, unsigned char* ws, unsigned* tcnt, int ntiles, int G, int bid, int tid) {
    pg8::MoeOrder So; So.tt = (const LAS int*)(lds + LDS_TT); So.tlist = TLIST; So.ntiles = ntiles; So.G = G; So.c = bid; So.estrideB = (size_t)1024 * 1024 * 2; So.tcnt = tcnt; So.mode = 1; So.tsbase = (unsigned*)(ws + WS_CTL) + CW_TS;
    pg8::EpiHid E{HID};
    pg8::gemm_phase<pg8::EpiHid, pg8::MoeOrder, true, true>(lds, Ub, (const bf16*)(ws + WS_WGU), D, So, E, tid);
}
static __device__ __forceinline__ void run_gemm_dn(LAS unsigned char* lds, unsigned char* ws, unsigned* tcnt, int ntiles, int G, int bid, int tid) {
    pg8::MoeOrder So; So.tt = (const LAS int*)(lds + LDS_TT); So.tlist = TLIST; So.ntiles = ntiles; So.G = G; So.c = G - 1 - bid; So.estrideB = (size_t)1024 * 512 * 2; So.tcnt = tcnt; So.mode = 2; So.tsbase = (unsigned*)(ws + WS_CTL) + CW_TS;
    pg8::EpiBf16 E{YB, D};
    pg8::gemm_phase<pg8::EpiBf16, pg8::MoeOrder, false, true>(lds, HID, (const bf16*)(ws + WS_WDN), DFF, So, E, tid);
}
#ifndef PH_MASK
#define PH_MASK 0xFFF
#endif
#define EN(b) (((PH_MASK) >> (b)) & 1)
#ifndef REPEAT_MASK
#define REPEAT_MASK 0
#endif
#define REPS(b) (1 + (((REPEAT_MASK) >> (b)) & 1))
#define IN(k) (lo <= (k) && (k) < hi && !(args.pflags & 256))
#define INS(k) (lo <= (k) && (k) < hi)
#if TS_ENABLE
#define SEAM(k) do { if (INS(k) && INS((k) + 1)) { __syncthreads(); if (threadIdx.x == 0) { unsigned* ts_ = (unsigned*)(args.ws + WS_CTL) + CW_TS + 4 * (k); const unsigned t_ = (unsigned)__builtin_amdgcn_s_memrealtime(); \
        atomicMax(ts_ + 1, t_); atomicAdd((unsigned long long*)(ts_ + 2), (unsigned long long)t_); } \
        xcd_barrier_impl(bar.bar, bar.x, bar.st); if (blockIdx.x == 0 && threadIdx.x == 0) ((unsigned*)(args.ws + WS_CTL))[CW_TS + 4 * (k)] = (unsigned)__builtin_amdgcn_s_memrealtime(); } } while (0)
#else
#define SEAM(k) do { if (INS(k) && INS((k) + 1)) { xcd_barrier_impl(bar.bar, bar.x, bar.st); } } while (0)
#endif


template <int L> __device__ __forceinline__ void layer_phases(const Args& args, Frame& F, const XcdBarrier& bar, const int lo, const int hi) {
    constexpr int l = L;
        const int pb = 2 + 9 * l;

        for (int rep_ = 0; rep_ < REPS(2); ++rep_) if (EN(2) && IN(pb + 0)) {
            PH_BEGIN();
            run_gemm_proj(F.lds, ws, args.in[(I_BIN) + zoff] + (size_t)l * NIN, l, G, bid, tid);
        }
        SEAM(pb + 0);

        for (int rep_ = 0; rep_ < REPS(3); ++rep_) if (EN(3) && IN(pb + 1)) {
            PH_BEGIN();
            if (!(args.pflags & 16)) phaseC_mlstm_all(F, ws, l);
            __syncthreads();
            if (L == 1) TS_POINT(33);
            if (!(args.pflags & 32)) { Frame Fu = F; asm volatile("" : "+v"(Fu.tid)); Fu.lane = Fu.tid & 63; phaseC_lru_all(Fu, ws, l); }
        }
        SEAM(pb + 1);

        for (int rep_ = 0; rep_ < REPS(4); ++rep_) if (EN(4) && IN(pb + 2)) {
            PH_BEGIN();
            const int NSCAN = (G >= 8) ? (G / 4) : 1;
            constexpr int NNS = 2;
            if (bid < NSCAN + NNS) { if (!(args.pflags & 512)) {
                LAS float* chs = (LAS float*)F.lds;
                LAS float* decT = chs + 2048;
                LAS float* scT = decT + 1024;
                for (int i = tid; i < 2048; i += 512) chs[i] = CHS[i];
                __syncthreads();
                LAS float* mArr = scT + 1024;
                if (tid < 8) { float m = 0.f;
#pragma unroll 8
                    for (int c = 0; c < NC; ++c) { const float bl = chs[(c * 8 + tid) * 2], a = chs[(c * 8 + tid) * 2 + 1]; mArr[tid * 128 + c] = m; m = fmaxf(bl + m, a); } }
                __syncthreads();
                for (int i = tid; i < 1024; i += 512) { const int h = i >> 7, c = i & 127; const float bl = chs[(c * 8 + h) * 2], a = chs[(c * 8 + h) * 2 + 1], m = mArr[i]; const float mn = fmaxf(bl + m, a);
                    decT[i] = __expf(bl + m - mn); scT[i] = __expf(a - mn); if (bid == 0) MST[c * 8 + h] = m; }
                __syncthreads();
                if (L == 1) TS_POINT(44);
                if (bid < NSCAN) {
                for (int slot = bid * 512 + tid; slot < 32768; slot += NSCAN * 512) {
                    const int h = slot >> 12, idx = (slot & 4095) * 4;
                    bf16* p = UC + (size_t)h * 16384 + idx;
                    float C0 = 0.f, C1 = 0.f, C2 = 0.f, C3 = 0.f;
#pragma unroll 1
                    for (int c0 = 0; c0 < NC; c0 += 32) {
                        u32x2 u[32];
#pragma unroll
                        for (int q = 0; q < 32; ++q) u[q] = *(const u32x2*)(p + (size_t)(c0 + q) * 131072);
#pragma unroll
                        for (int q = 0; q < 32; ++q) { const float dec = decT[h * 128 + c0 + q], sc = scT[h * 128 + c0 + q];
                            u32x2 o; o.x = pk2(C0, C1); o.y = pk2(C2, C3);
                            *(u32x2*)(p + (size_t)(c0 + q) * 131072) = o;
                            C0 = dec * C0 + sc * bflo(u[q].x); C1 = dec * C1 + sc * bfhi(u[q].x); C2 = dec * C2 + sc * bflo(u[q].y); C3 = dec * C3 + sc * bfhi(u[q].y); }
                    }
                }
                }
                if (bid >= NSCAN && bid < NSCAN + NNS) {
                for (int id = (bid - NSCAN) * 512 + tid; id < 1024; id += NNS * 512) {
                    const int h = id >> 7, d = id & 127; float nn = 0.f;
#pragma unroll 1
                    for (int c0 = 0; c0 < NC; c0 += 64) {
                        float nl[64];
#pragma unroll
                        for (int q = 0; q < 64; ++q) nl[q] = NLOC[((c0 + q) * 8 + h) * 128 + d];
#pragma unroll
                        for (int q = 0; q < 64; ++q) { NST[((c0 + q) * 8 + h) * 128 + d] = nn; nn = decT[h * 128 + c0 + q] * nn + scT[h * 128 + c0 + q] * nl[q]; }
                    }
                }
                }
                if (L == 1) TS_POINT(45);
            } } else {
                const int idx = bid - NSCAN - NNS, nw8 = (G - NSCAN - NNS) >> 3;
                if (idx < nw8 * 8 && !(args.pflags & 1024)) {
                    const int n = idx & 7, slot = idx >> 3;
                    LAS float* T = (LAS float*)F.lds;
                    LAS float* ptot = T + 16384;
                    {
                        const int d = tid & 127, part = tid >> 7; const int ch = n * 128 + d;
                        float A[32], Hh[32];
#pragma unroll
                        for (int q = 0; q < 32; ++q) { A[q] = AC[(part * 32 + q) * 1024 + ch]; Hh[q] = HC[(part * 32 + q) * 1024 + ch]; }
                        float P = 1.f, Hs = 0.f;
#pragma unroll
                        for (int q = 0; q < 32; ++q) { Hs = A[q] * Hs + Hh[q]; P *= A[q]; }
                        ptot[(part * 128 + d) * 2] = P; ptot[(part * 128 + d) * 2 + 1] = Hs;
                        __syncthreads();
                        float st = 0.f;
                        for (int pp = 0; pp < part; ++pp) st = ptot[(pp * 128 + d) * 2] * st + ptot[(pp * 128 + d) * 2 + 1];
#pragma unroll
                        for (int q = 0; q < 32; ++q) { T[(part * 32 + q) * 128 + d] = st; st = A[q] * st + Hh[q]; }
                    }
                    __syncthreads();
                    const int li = lane & 15, rsub = lane >> 4;
                    const float* gp = args.in[(I_LRUG) + zoff] + l * 1024 + n * 128 + 8 * li;
                    const f32x4 gn0 = *(const f32x4*)gp, gn1 = *(const f32x4*)(gp + 4);
                    u32x4 hn[4], pn[4], gn_[4];
#define DL_LOAD(CC) do { _Pragma("unroll") for (int it = 0; it < 4; ++it) { const size_t gofs = ((size_t)(CC) * CH + wave * 16 + it * 4 + rsub) * D + n * 128 + 8 * li; \
                        hn[it] = *(const u32x4*)(HLOC + gofs); pn[it] = *(const u32x4*)(PCUM + gofs); gn_[it] = *(const u32x4*)(GRb + gofs); } } while (0)
                    if (slot < NC) DL_LOAD(slot);
#pragma unroll 1
                    for (int c = slot; c < NC; c += nw8) {
                        const f32x4 ca = *(const LAS f32x4*)(T + c * 128 + 8 * li), cb = *(const LAS f32x4*)(T + c * 128 + 8 * li + 4);
                        u32x4 hv[4], pv[4], gv[4];
#pragma unroll
                        for (int it = 0; it < 4; ++it) { hv[it] = hn[it]; pv[it] = pn[it]; gv[it] = gn_[it]; }
                        if (c + nw8 < NC) DL_LOAD(c + nw8);
#pragma unroll
                        for (int it = 0; it < 4; ++it) {
                            float y[8];
                            y[0] = (bflo(hv[it].x) + bflo(pv[it].x) * ca.x) * gelu_tanh_f(bflo(gv[it].x)); y[1] = (bfhi(hv[it].x) + bfhi(pv[it].x) * ca.y) * gelu_tanh_f(bfhi(gv[it].x));
                            y[2] = (bflo(hv[it].y) + bflo(pv[it].y) * ca.z) * gelu_tanh_f(bflo(gv[it].y)); y[3] = (bfhi(hv[it].y) + bfhi(pv[it].y) * ca.w) * gelu_tanh_f(bfhi(gv[it].y));
                            y[4] = (bflo(hv[it].z) + bflo(pv[it].z) * cb.x) * gelu_tanh_f(bflo(gv[it].z)); y[5] = (bfhi(hv[it].z) + bfhi(pv[it].z) * cb.y) * gelu_tanh_f(bfhi(gv[it].z));
                            y[6] = (bflo(hv[it].w) + bflo(pv[it].w) * cb.z) * gelu_tanh_f(bflo(gv[it].w)); y[7] = (bfhi(hv[it].w) + bfhi(pv[it].w) * cb.w) * gelu_tanh_f(bfhi(gv[it].w));
                            float ss = (y[0] * y[0] + y[1] * y[1]) + (y[2] * y[2] + y[3] * y[3]) + (y[4] * y[4] + y[5] * y[5]) + (y[6] * y[6] + y[7] * y[7]);
                            ss = row16_sum(ss);
                            const float rs = __builtin_amdgcn_rsqf(ss * (1.f / 128.f) + LN_EPS);
                            u32x4 o; o.x = pk2(y[0] * rs * gn0.x, y[1] * rs * gn0.y); o.y = pk2(y[2] * rs * gn0.z, y[3] * rs * gn0.w); o.z = pk2(y[4] * rs * gn1.x, y[5] * rs * gn1.y); o.w = pk2(y[6] * rs * gn1.z, y[7] * rs * gn1.w);
                            *(u32x4*)(Yb + ((size_t)c * CH + wave * 16 + it * 4 + rsub) * 2048 + 1024 + n * 128 + 8 * li) = o;
                        }
                    }
                }
            }
        }
#undef DL_LOAD
#if TS_ENABLE
        if (L == 1 && INS(pb + 2) && (int)blockIdx.x >= ((int)gridDim.x >= 8 ? (int)gridDim.x / 4 : 1)) TS_POINT(46);
#endif
        SEAM(pb + 2);

        for (int rep_ = 0; rep_ < REPS(5); ++rep_) if (EN(5) && IN(pb + 3)) {
            PH_BEGIN();
            for (int i = tid; i < 14 * 136 / 2; i += 512) ((LAS unsigned*)(F.lds + 69632 + 130 * 272))[i] = 0u;
            __syncthreads();
            phaseE_all(F, ws, l);
        }
        SEAM(pb + 3);

        for (int rep_ = 0; rep_ < REPS(6); ++rep_) if (EN(6) && IN(pb + 4)) {
            PH_BEGIN();
            run_gemm_out(F.lds, ws, l, G, bid, tid);
        }
        SEAM(pb + 4);

        for (int rep_ = 0; rep_ < REPS(7); ++rep_) if (EN(7) && IN(pb + 5)) {
            PH_BEGIN();
            constexpr int UP = 1032;
            LAS bf16* UH = (LAS bf16*)(F.lds); LAS bf16* UL = (LAS bf16*)(F.lds + 33024);
            LAS float* part = (LAS float*)(F.lds + 66048);
            LAS float* vecs = (LAS float*)(F.lds + 82432);
            LAS int* rinfo = (LAS int*)(F.lds + 102912);
            LAS int* lcnt = (LAS int*)(F.lds + 102912 + 4096);
            const int g = lane >> 4, li = lane & 15;
            bf16x8 bh[4][2], bl[4][2];
            {
                LAS float* wst = (LAS float*)F.lds;
                const f32x4* wsrc = (const f32x4*)args.in[(I_WR) + zoff];
#pragma unroll
                for (int it = 0; it < 16; ++it) *(LAS f32x4*)(wst + 4 * (tid + it * 512)) = wsrc[tid + it * 512];
                __syncthreads();
#pragma unroll
                for (int ks = 0; ks < 4; ++ks)
#pragma unroll
                    for (int nt = 0; nt < 2; ++nt)
#pragma unroll
                        for (int j = 0; j < 8; ++j) { const float wv = wst[(128 * wave + 32 * ks + 8 * g + j) * 32 + 16 * nt + li]; const unsigned hi = f2bf(wv);
                            bh[ks][nt][j] = (short)hi; bl[ks][nt][j] = (short)f2bf(wv - bf2f(hi)); }
                __syncthreads();
            }
            {
                const float* lng = args.in[(I_LNG) + zoff] + (size_t)(l * 2 + 0) * D; const float* lnb = args.in[(I_LNB) + zoff] + (size_t)(l * 2 + 0) * D;
                if (tid < 64) lcnt[tid] = 0;
                if (tid < 32) ((LAS float*)lcnt)[64 + tid] = args.in[(I_BR) + zoff][tid];
                for (int i = tid; i < 1024; i += 512) { vecs[i] = ada[2048 + i]; vecs[1024 + i] = lng[i]; vecs[2048 + i] = lnb[i]; vecs[3072 + i] = 1.0f + ada[4096 + i]; vecs[4096 + i] = ada[3072 + i]; }
            }
            __syncthreads();
            if (L == 1) TS_POINT(32);
            const float* xin = args.in[(I_X) + zoff];
            f32x4 xp[2][4]; u32x2 xq[2][4], yp[2][4];
#define G_LOADROWS(GRP) do { _Pragma("unroll") for (int q = 0; q < 2; ++q) _Pragma("unroll") for (int j = 0; j < 4; ++j) { const size_t o = (size_t)((GRP) * 16 + 2 * wave + q) * D; \
        if constexpr (L == 0) xp[q][j] = *(const f32x4*)(xin + o + (256 * j + 4 * lane)); else xq[q][j] = *(const u32x2*)(XB + o + (256 * j + 4 * lane)); \
        yp[q][j] = *(const u32x2*)(YO + o + (256 * j + 4 * lane)); } } while (0)
            if (bid < S / 16) G_LOADROWS(bid);
#if TS_ENABLE
            unsigned long long ga_ = 0, gb_ = 0, gc_ = 0;
#endif
#pragma unroll 1
            for (int grp = bid, gl = 0; grp < S / 16; grp += G, ++gl) {
                const int base = grp * 16;
#if TS_ENABLE
                const unsigned long long g0_ = __builtin_amdgcn_s_memrealtime();
#endif
                f32x4 v[2][4];
#pragma unroll
                for (int q = 0; q < 2; ++q)
#pragma unroll
                    for (int j = 0; j < 4; ++j) { f32x4 xv, yv; if constexpr (L == 0) xv = xp[q][j]; else { xv.x = bflo(xq[q][j].x); xv.y = bfhi(xq[q][j].x); xv.z = bflo(xq[q][j].y); xv.w = bfhi(xq[q][j].y); }
                        yv.x = bflo(yp[q][j].x); yv.y = bfhi(yp[q][j].x); yv.z = bflo(yp[q][j].y); yv.w = bfhi(yp[q][j].y);
                        v[q][j] = xv * ALPHA + *(const LAS f32x4*)(vecs + 256 * j + 4 * lane) * yv; }
                if (grp + G < S / 16) G_LOADROWS(grp + G);
                ln_row(v[0]); ln_row(v[1]);
#pragma unroll
                for (int q = 0; q < 2; ++q)
#pragma unroll
                    for (int j = 0; j < 4; ++j) { const int k = 256 * j + 4 * lane; v[q][j] = v[q][j] * *(const LAS f32x4*)(vecs + 1024 + k) + *(const LAS f32x4*)(vecs + 2048 + k);
                        u32x2 xw; xw.x = pk2(v[q][j].x, v[q][j].y); xw.y = pk2(v[q][j].z, v[q][j].w); *(u32x2*)(XB + (size_t)(base + 2 * wave + q) * D + (unsigned)k) = xw; }
                ln_row(v[0]); ln_row(v[1]);
#pragma unroll
                for (int q = 0; q < 2; ++q)
#pragma unroll
                    for (int j = 0; j < 4; ++j) { const int k = 256 * j + 4 * lane; const f32x4 u = v[q][j] * *(const LAS f32x4*)(vecs + 3072 + k) + *(const LAS f32x4*)(vecs + 4096 + k);
                        const unsigned h0 = f2bf(u.x), h1 = f2bf(u.y), h2 = f2bf(u.z), h3 = f2bf(u.w);
                        u32x2 wh; wh.x = h0 | (h1 << 16); wh.y = h2 | (h3 << 16);
                        u32x2 wl; wl.x = pk2(u.x - bf2f(h0), u.y - bf2f(h1)); wl.y = pk2(u.z - bf2f(h2), u.w - bf2f(h3));
                        *(u32x2*)(Ub + (size_t)(base + 2 * wave + q) * D + (unsigned)k) = wh;
                        *(LAS u32x2*)(UH + (2 * wave + q) * UP + k) = wh; *(LAS u32x2*)(UL + (2 * wave + q) * UP + k) = wl; }
                lds_barrier();
#if TS_ENABLE
                const unsigned long long g1_ = __builtin_amdgcn_s_memrealtime(); ga_ += g1_ - g0_;
#endif
                if (!(args.pflags & 4)) {
                    f32x4 a0 = {0.f, 0.f, 0.f, 0.f}, a1 = {0.f, 0.f, 0.f, 0.f};
#pragma unroll
                    for (int ks = 0; ks < 4; ++ks) {
                        const bf16x8 ah = *(const LAS bf16x8*)(UH + li * UP + 128 * wave + 32 * ks + 8 * g), al = *(const LAS bf16x8*)(UL + li * UP + 128 * wave + 32 * ks + 8 * g);
                        a0 = mfma16(ah, bh[ks][0], a0); a0 = mfma16(ah, bl[ks][0], a0); a0 = mfma16(al, bh[ks][0], a0);
                        a1 = mfma16(ah, bh[ks][1], a1); a1 = mfma16(ah, bl[ks][1], a1); a1 = mfma16(al, bh[ks][1], a1);
                    }
#pragma unroll
                    for (int r = 0; r < 4; ++r) { part[(wave * 16 + 4 * g + r) * 32 + li] = a0[r]; part[(wave * 16 + 4 * g + r) * 32 + 16 + li] = a1[r]; }
                }
                lds_barrier();
#if TS_ENABLE
                const unsigned long long g2_ = __builtin_amdgcn_s_memrealtime(); gb_ += g2_ - g1_;
#endif
                if (!(args.pflags & 2)) {
                    const int row = tid >> 5, e = tid & 31;
                    float logit = 0.f;
#pragma unroll
                    for (int w8 = 0; w8 < 8; ++w8) logit += part[(w8 * 16 + row) * 32 + e];
                    const float aff = sigmoid_f(logit); const float sel = aff + ((const LAS float*)lcnt)[64 + e];
                    const int hb = lane & 32, gb = lane & ~3;
                    const float s0 = __shfl(sel, gb), s1 = __shfl(sel, gb + 1), s2 = __shfl(sel, gb + 2), s3 = __shfl(sel, gb + 3);
                    float t1 = s0; int i1 = 0; if (s1 > t1) { t1 = s1; i1 = 1; } if (s2 > t1) { t1 = s2; i1 = 2; } if (s3 > t1) { t1 = s3; i1 = 3; }
                    float t2 = -3.0e38f; if (i1 != 0) t2 = s0; if (i1 != 1 && s1 > t2) t2 = s1; if (i1 != 2 && s2 > t2) t2 = s2; if (i1 != 3 && s3 > t2) t2 = s3;
                    float gs = t1 + t2; int gi = e >> 2;
#pragma unroll
                    for (int o = 4; o < 32; o <<= 1) { const float og = __shfl_xor(gs, o); const int oi = __shfl_xor(gi, o); if (og > gs || (og == gs && oi < gi)) { gs = og; gi = oi; } }
                    const float b0 = __shfl(sel, hb + gi * 4), b1 = __shfl(sel, hb + gi * 4 + 1), b2 = __shfl(sel, hb + gi * 4 + 2), b3 = __shfl(sel, hb + gi * 4 + 3);
                    const float a0 = __shfl(aff, hb + gi * 4), a1 = __shfl(aff, hb + gi * 4 + 1), a2 = __shfl(aff, hb + gi * 4 + 2), a3 = __shfl(aff, hb + gi * 4 + 3);
                    float u1 = b0; int j1 = 0; if (b1 > u1) { u1 = b1; j1 = 1; } if (b2 > u1) { u1 = b2; j1 = 2; } if (b3 > u1) { u1 = b3; j1 = 3; }
                    float u2 = -3.0e38f; int j2 = 0;
                    if (j1 != 0) { u2 = b0; j2 = 0; }
                    if (j1 != 1 && b1 > u2) { u2 = b1; j2 = 1; }
                    if (j1 != 2 && b2 > u2) { u2 = b2; j2 = 2; }
                    if (j1 != 3 && b3 > u2) { u2 = b3; j2 = 3; }
                    const float af1 = (j1 == 0) ? a0 : (j1 == 1) ? a1 : (j1 == 2) ? a2 : a3;
                    const float af2 = (j2 == 0) ? a0 : (j2 == 1) ? a1 : (j2 == 2) ? a2 : a3;
                    const float inv = 1.f / (af1 + af2);
                    if (e == 0 && gl < 8) {
                        const int me0 = gi * 4 + j1, me1 = gi * 4 + j2; LAS int* ri = rinfo + (gl * 16 + row) * 8;
                        ri[0] = me0; ri[1] = me1; ri[2] = __hip_atomic_fetch_add(lcnt + me0, 1, __ATOMIC_RELAXED, __HIP_MEMORY_SCOPE_WORKGROUP); ri[3] = __hip_atomic_fetch_add(lcnt + me1, 1, __ATOMIC_RELAXED, __HIP_MEMORY_SCOPE_WORKGROUP);
                        ((LAS float*)ri)[4] = af1 * inv; ((LAS float*)ri)[5] = af2 * inv; ri[6] = base + row;
                    }
                }
#if TS_ENABLE
                gc_ += __builtin_amdgcn_s_memrealtime() - g2_;
#endif
            }
#if TS_ENABLE
            if (tid == 0 && L == 1) { unsigned* tsb = (unsigned*)(ws + WS_CTL) + CW_TS; atomicAdd((unsigned long long*)(tsb + 4 * 40 + 2), ga_); atomicAdd((unsigned long long*)(tsb + 4 * 41 + 2), gb_); atomicAdd((unsigned long long*)(tsb + 4 * 42 + 2), gc_); }
#endif
            lds_barrier();
            if (tid < 32 && !(args.pflags & 1)) lcnt[32 + tid] = (int)atomicAdd(ECNT + 64 * tid, (unsigned)lcnt[tid]);
            __syncthreads();
            if (tid < 128 && tid < 16 * ((S / 16 - bid + G - 1) / G) && !(args.pflags & 1)) {
                const LAS int* ri = rinfo + tid * 8; const int me0 = ri[0], me1 = ri[1], tok = ri[6];
                const int p0 = lcnt[32 + me0] + ri[2], p1 = lcnt[32 + me1] + ri[3];
                TLIST[me0 * 16384 + p0] = tok; TLIST[me1 * 16384 + p1] = tok;
                TOKE[tok * 2] = me0; TOKE[tok * 2 + 1] = me1; TOKP[tok * 2] = p0; TOKP[tok * 2 + 1] = p1; TOKG[tok * 2] = ((const LAS float*)ri)[4]; TOKG[tok * 2 + 1] = ((const LAS float*)ri)[5];
            }
        }
#undef G_LOADROWS
        SEAM(pb + 5);

        for (int rep_ = 0; rep_ < REPS(8); ++rep_) if (EN(8) && IN(pb + 6)) {
            PH_BEGIN();
            const int ntiles = build_tile_table(F, l);
            run_gemm_gu(F.lds, ws, (unsigned*)(ws + WS_CTL) + CW_TILE + l * 4096, ntiles, G, bid, tid);
        }
#if TS_ENABLE
        if (INS(pb + 6)) { __syncthreads(); if (threadIdx.x == 0) { unsigned* ts_ = (unsigned*)(args.ws + WS_CTL) + CW_TS + 4 * (pb + 6); const unsigned t_ = (unsigned)__builtin_amdgcn_s_memrealtime(); atomicMax(ts_ + 1, t_); atomicAdd((unsigned long long*)(ts_ + 2), (unsigned long long)t_); } }
#endif

        for (int rep_ = 0; rep_ < REPS(9); ++rep_) if (EN(9) && IN(pb + 7)) {
            PH_BEGIN();
            const int ntiles = IN(pb + 6) ? ((const LAS int*)(F.lds + LDS_TT))[64] : build_tile_table(F, l);
            run_gemm_dn(F.lds, ws, (unsigned*)(ws + WS_CTL) + CW_TILE + l * 4096, ntiles, G, bid, tid);
        }
        SEAM(pb + 7);

        for (int rep_ = 0; rep_ < REPS(10); ++rep_) if (EN(10) && IN(pb + 8)) {
            PH_BEGIN();
            if (!(IN(pb + 6) && IN(pb + 7))) (void)build_tile_table(F, l);
            const LAS int* tt = (const LAS int*)(F.lds + LDS_TT);
            if (l + 1 < DEPTH) {
                LAS float* scr = (LAS float*)(F.lds + wave * 16896);
                for (int it = gw; it < 12288; it += NGW) conv_moe_item(F, l + 1, it, scr);
                __syncthreads();
                load_wif(F, l + 1, (LAS float*)F.lds);
                __syncthreads();
            }
            LAS float* vecs = (LAS float*)(F.lds + 65536);
            {
                const float* lng = args.in[(I_LNG) + zoff] + (size_t)(l * 2 + 1) * D; const float* lnb = args.in[(I_LNB) + zoff] + (size_t)(l * 2 + 1) * D;
                for (int i = tid; i < 1024; i += 512) { vecs[i] = ada[5120 + i]; vecs[1024 + i] = lng[i]; vecs[2048 + i] = lnb[i];
                    if (l + 1 < DEPTH) { vecs[3072 + i] = ADA[(l + 1) * 6144 + i]; vecs[4096 + i] = 1.0f + ADA[(l + 1) * 6144 + 1024 + i]; } }
                __syncthreads();
            }
            float bq_next = 0.f; if (l + 1 < DEPTH) bq_next = args.in[(I_BIN) + zoff][(size_t)(l + 1) * NIN + 4096 + 8 * (lane >> 5) + 4 * ((lane >> 4) & 1) + (lane & 3)];
            {
                int ie0 = 0, ie1 = 0, ip0 = 0, ip1 = 0; float ig0 = 0.f, ig1 = 0.f;
                int ce0 = 0, ce1 = 0, cp0 = 0, cp1 = 0; float cg0 = 0.f, cg1 = 0.f;
                u32x2 ya[4], yb[4], xr[4]; float ng0 = 0.f, ng1 = 0.f;
#define J_INFO(ROW, E0, E1, P0, P1, G0, G1) do { E0 = TOKE[(ROW) * 2]; E1 = TOKE[(ROW) * 2 + 1]; P0 = TOKP[(ROW) * 2]; P1 = TOKP[(ROW) * 2 + 1]; G0 = TOKG[(ROW) * 2]; G1 = TOKG[(ROW) * 2 + 1]; } while (0)
#define J_DATA(ROW, E0, E1, P0, P1) do { const int j0_ = (P0) >> 8, j1_ = (P1) >> 8; \
        const size_t r0_ = (size_t)((j0_ < tt[225 + (E0)]) ? tt[32 + (E0)] + j0_ : tt[257 + (E0)]) * 256 + ((P0) & 255), r1_ = (size_t)((j1_ < tt[225 + (E1)]) ? tt[32 + (E1)] + j1_ : tt[257 + (E1)]) * 256 + ((P1) & 255); \
        _Pragma("unroll") for (int j = 0; j < 4; ++j) { const int k = 256 * j + 4 * lane; ya[j] = *(const u32x2*)(YB + r0_ * D + k); yb[j] = *(const u32x2*)(YB + r1_ * D + k); xr[j] = *(const u32x2*)(XB + (size_t)(ROW) * D + k); } } while (0)
                if (gw < S) { J_INFO(gw, ce0, ce1, cp0, cp1, cg0, cg1); J_DATA(gw, ce0, ce1, cp0, cp1); ng0 = cg0; ng1 = cg1; }
                if (gw + NGW < S) J_INFO(gw + NGW, ce0, ce1, cp0, cp1, cg0, cg1);
#pragma unroll 1
                for (int row = gw; row < S; row += NGW) {
                    const float g0 = ng0, g1 = ng1;
                    f32x4 v[4];
#pragma unroll
                    for (int j = 0; j < 4; ++j) { const int k = 256 * j + 4 * lane;
                        f32x4 y; y.x = g0 * bflo(ya[j].x) + g1 * bflo(yb[j].x); y.y = g0 * bfhi(ya[j].x) + g1 * bfhi(yb[j].x); y.z = g0 * bflo(ya[j].y) + g1 * bflo(yb[j].y); y.w = g0 * bfhi(ya[j].y) + g1 * bfhi(yb[j].y);
                        f32x4 xv; xv.x = bflo(xr[j].x); xv.y = bfhi(xr[j].x); xv.z = bflo(xr[j].y); xv.w = bfhi(xr[j].y); const f32x4 g2 = *(const LAS f32x4*)(vecs + k);
                        v[j] = xv * ALPHA + g2 * y; }
                    if (row + NGW < S) { J_DATA(row + NGW, ce0, ce1, cp0, cp1); ng0 = cg0; ng1 = cg1; }
                    if (row + 2 * NGW < S) J_INFO(row + 2 * NGW, ce0, ce1, cp0, cp1, cg0, cg1);
                    ln_row(v);
#pragma unroll
                    for (int j = 0; j < 4; ++j) { const int k = 256 * j + 4 * lane; v[j] = v[j] * *(const LAS f32x4*)(vecs + 1024 + k) + *(const LAS f32x4*)(vecs + 2048 + k);
                        if constexpr (L + 1 < DEPTH) { u32x2 xw; xw.x = pk2(v[j].x, v[j].y); xw.y = pk2(v[j].z, v[j].w); *(u32x2*)(XB + (size_t)row * D + k) = xw; } else *(f32x4*)(args.out + (size_t)row * D + k) = v[j]; }
                    if (l + 1 < DEPTH) {
                        ln_row(v);
                        emit_u(F, v, vecs + 3072, vecs + 4096, row, (const LAS float*)F.lds, bq_next);
                    }
                }
#undef J_INFO
#undef J_DATA
                (void)ie0; (void)ie1; (void)ip0; (void)ip1; (void)ig0; (void)ig1;
            }
        }
        SEAM(pb + 8);
}

__global__ void __launch_bounds__(512, 2) fwd(Args args) {
    extern __shared__ __attribute__((aligned(16))) unsigned char lds_raw[];
    Frame F;
    F.lds = (LAS unsigned char*)lds_raw;
    F.tid = threadIdx.x; F.lane = F.tid & 63; F.wave = __builtin_amdgcn_readfirstlane(F.tid >> 6);
    F.G = gridDim.x; F.bid = blockIdx.x;
    F.in = args.in; F.out = args.out; F.ws = args.ws; F.zoff = 0; F.pflags = args.pflags;
    const int tid0 = threadIdx.x;
    unsigned char* ws0 = args.ws;
    const int lo = args.ph_lo, hi = args.ph_hi;
    volatile LAS unsigned* MISC = (volatile LAS unsigned*)(F.lds + LDS_MISC);
    if (tid0 < 64) MISC[tid0] = 0u;
    __syncthreads();
    XcdBarrier bar; bar.bar = (unsigned*)(ws0 + WS_CTL) + CW_BAR; bar.x = 0; bar.st = MISC + 8;
#if TS_ENABLE
    if (blockIdx.x == 0 && threadIdx.x == 0 && args.ph_lo == 0) ((unsigned*)(args.ws + WS_CTL))[CW_TS + 512] = (unsigned)__builtin_amdgcn_s_memrealtime();
#endif
    const bool multi = (hi - lo) > 1;
    if (multi) bar = xcd_barrier_post((unsigned*)(ws0 + WS_CTL) + CW_BAR, MISC + 8);
    for (int rep_ = 0; rep_ < REPS(0); ++rep_) if (EN(0) && IN(0)) {
        PH_BEGIN();
        unsigned* ada_cnt = (unsigned*)(ws + WS_CTL) + CW_ADA;
        {
            LAS float* red = (LAS float*)F.lds;
            const float* c = args.in[(I_C) + zoff];
            for (int g = bid; g < 256; g += G) {
                const int l = g >> 7, n0 = (g & 127) * 48, c4 = tid % 12, kq = tid / 12;
                if (kq < 42) {
                    const float* w = args.in[(I_WADA) + zoff] + (size_t)l * D * 6144 + n0 + c4 * 4;
                    f32x4 acc = {0.f, 0.f, 0.f, 0.f};
#pragma unroll 5
                    for (int k = kq; k < D; k += 42) { const float cv = silu_f(c[k]); const f32x4 wv = *(const f32x4*)(w + (size_t)k * 6144); acc += wv * cv; }
                    *(LAS f32x4*)(red + kq * 48 + c4 * 4) = acc;
                }
                __syncthreads();
                if (tid < 48) { float s = 0.f; for (int q = 0; q < 42; ++q) s += red[q * 48 + tid];
                    __hip_atomic_store(ADA + l * 6144 + n0 + tid, s + args.in[(I_BADA) + zoff][l * 6144 + n0 + tid], __ATOMIC_RELAXED, __HIP_MEMORY_SCOPE_AGENT);
                    asm volatile("s_waitcnt vmcnt(0)" ::: "memory");
                    if (tid == 0 && rep_ == 0) __hip_atomic_fetch_add(ada_cnt, 1u, __ATOMIC_RELAXED, __HIP_MEMORY_SCOPE_AGENT); }
                __syncthreads();
            }
        }
#if TS_ENABLE
        { __syncthreads(); if (threadIdx.x == 0) { unsigned* ts_ = (unsigned*)(args.ws + WS_CTL) + CW_TS + 4 * (20); const unsigned t_ = (unsigned)__builtin_amdgcn_s_memrealtime(); atomicMax(ts_ + 1, t_); atomicAdd((unsigned long long*)(ts_ + 2), (unsigned long long)t_); } }
#endif
        LAS float* scr = (LAS float*)(F.lds + wave * 16896);
        for (int it = gw; it < 2 * 2112; it += NGW) conv_dense_item(F, it, scr);
        for (int it = gw; it < 12288; it += NGW) conv_moe_item(F, 0, it, scr);
#if TS_ENABLE
        { __syncthreads(); if (threadIdx.x == 0) { unsigned* ts_ = (unsigned*)(args.ws + WS_CTL) + CW_TS + 4 * (21); const unsigned t_ = (unsigned)__builtin_amdgcn_s_memrealtime(); atomicMax(ts_ + 1, t_); atomicAdd((unsigned long long*)(ts_ + 2), (unsigned long long)t_); } }
#endif
        __syncthreads();
        if (tid == 0) { unsigned sp = 0; while (__hip_atomic_load(ada_cnt, __ATOMIC_RELAXED, __HIP_MEMORY_SCOPE_AGENT) < 256u) { __builtin_amdgcn_s_sleep(2); if (++sp > (1u << 22)) break; }
            __builtin_amdgcn_fence(__ATOMIC_ACQUIRE, "agent"); asm volatile("s_waitcnt vmcnt(0)" ::: "memory"); }
        __syncthreads();
        LAS float* Wif = (LAS float*)F.lds;
        load_wif(F, 0, Wif);
        LAS float* vecs = (LAS float*)(F.lds + 65536);
        for (int i = tid; i < 1024; i += 512) { vecs[i] = ADA[i]; vecs[1024 + i] = 1.0f + ADA[1024 + i]; }
        __syncthreads();
        const float* x = args.in[(I_X) + zoff];
        const float bq0 = args.in[(I_BIN) + zoff][4096 + 8 * (lane >> 5) + 4 * ((lane >> 4) & 1) + (lane & 3)];
        {
            f32x4 xn[4];
            if (gw < S) {
#pragma unroll
                for (int j = 0; j < 4; ++j) xn[j] = *(const f32x4*)(x + (size_t)gw * D + 256 * j + 4 * lane); }
#pragma unroll 1
            for (int row = gw; row < S; row += NGW) {
                f32x4 v[4];
#pragma unroll
                for (int j = 0; j < 4; ++j) v[j] = xn[j];
                if (row + NGW < S) {
#pragma unroll
                    for (int j = 0; j < 4; ++j) xn[j] = *(const f32x4*)(x + (size_t)(row + NGW) * D + 256 * j + 4 * lane); }
                ln_row(v);
                emit_u(F, v, vecs, vecs + 1024, row, Wif, bq0);
            }
        }
    }
    SEAM(1);

    layer_phases<0>(args, F, bar, lo, hi);
    layer_phases<1>(args, F, bar, lo, hi);
#undef IN
#undef INS
#undef SEAM
}

#if TS_ENABLE
__global__ void ts_spin(const unsigned* ctl) {
    const unsigned* ts = ctl + CW_TS; const int seams[] = {1, 2, 3, 4, 5, 6, 7, 9, 10, 11, 12, 13, 14, 15, 16, 18, 19};
    long long v = 0;
    if (TS_SEL == 1) { for (int i = 0; i < 17; ++i) { const int k = seams[i]; const unsigned long long sum = *(const unsigned long long*)(ts + 4 * k + 2); v += (long long)ts[4 * k + 1] - (long long)(sum / gridDim.y); } }
    else if (TS_SEL == 2) { for (int i = 0; i < 17; ++i) { const int k = seams[i]; v += (long long)ts[4 * k] - (long long)ts[4 * k + 1]; } }
    else if (TS_SEL >= 100 && TS_SEL < 200) { const int k = TS_SEL - 100; int kp = k - 1; while (kp > 0 && ts[4 * kp] == 0u) --kp; const unsigned prev = (kp <= 0 || ts[4 * kp] == 0u) ? ts[512] : ts[4 * kp]; v = (long long)ts[4 * k] - (long long)prev; }
    else if (TS_SEL >= 900) { const int k = TS_SEL - 900; v = (long long)ts[4 * k + 1] - (long long)ts[4 * TS_REF]; }
    else if (TS_SEL >= 800) { const int k = TS_SEL - 800; const unsigned long long sum = *(const unsigned long long*)(ts + 4 * k + 2); v = (long long)(sum / gridDim.y) - (long long)ts[4 * TS_REF]; }
    else if (TS_SEL >= 700) { const int k = TS_SEL - 700; v = (long long)(*(const unsigned long long*)(ts + 4 * k + 2) / gridDim.y); }
    else if (TS_SEL >= 500) { const int k = (TS_SEL >= 600) ? TS_SEL - 600 : TS_SEL - 500; const unsigned long long sum = *(const unsigned long long*)(ts + 4 * k + 2); v = (TS_SEL >= 600) ? (long long)(sum / gridDim.y) - (long long)ts[512] : (long long)ts[4 * k + 1] - (long long)ts[512]; }
    else if (TS_SEL >= 300) { const int k = (TS_SEL >= 400) ? TS_SEL - 400 : TS_SEL - 300; int kp = k - 1; while (kp > 0 && ts[4 * kp] == 0u) --kp; const unsigned prev = (kp <= 0 || ts[4 * kp] == 0u) ? ts[512] : ts[4 * kp];
        const unsigned long long sum = *(const unsigned long long*)(ts + 4 * k + 2); v = (TS_SEL >= 400) ? (long long)(sum / gridDim.y) - (long long)prev : (long long)ts[4 * k + 1] - (long long)prev; }
    else if (TS_SEL >= 200) { const int k = TS_SEL - 200; const unsigned long long sum = *(const unsigned long long*)(ts + 4 * k + 2); v = (long long)ts[4 * k + 1] - (long long)(sum / gridDim.y); }
    if (v < 0) v = 0; if (v > 2000000) v = 2000000;
    const unsigned long long t0 = __builtin_amdgcn_s_memrealtime(), need = (unsigned long long)v * TS_AMP;
    while (__builtin_amdgcn_s_memrealtime() - t0 < need) __builtin_amdgcn_s_sleep(4);
}
#endif
#ifndef TS_ENABLE
#define TS_ENABLE 0
#endif
#ifndef TS_SEL
#define TS_SEL 0
#endif
#ifndef TS_AMP
#define TS_AMP 10
#endif
#ifndef PROBE_PHASE
#define PROBE_PHASE -1
#endif
#ifndef PROBE_FLAGS
#define PROBE_FLAGS 0
#endif
#ifndef PROBE_SPAN
#define PROBE_SPAN 0
#endif
#ifndef N_LAUNCH_MODE
#define N_LAUNCH_MODE 1
#endif
extern "C" void kernel_launch(void* const* d_in, const int* in_sizes, int n_in, void* d_out, int out_size, void* d_ws, size_t ws_size, hipStream_t stream) {
    static int grid = 0;
    if (grid == 0) {
        if (n_in != 25 || out_size != S * D || ws_size < WS_END) { fprintf(stderr, "kernel_launch: unexpected shapes: n_in %d out %d ws %zu\n", n_in, out_size, ws_size); grid = -1; return; }
        int dev = 0, cus = 0;
        if (hipGetDevice(&dev) != hipSuccess || hipDeviceGetAttribute(&cus, hipDeviceAttributeMultiprocessorCount, dev) != hipSuccess) { grid = -1; return; }
        if (hipFuncSetAttribute((const void*)fwd, hipFuncAttributeMaxDynamicSharedMemorySize, LDS_BYTES) != hipSuccess) { fprintf(stderr, "kernel_launch: hipFuncSetAttribute failed\n"); grid = -1; return; }
        int per_cu = 0;
        if (hipOccupancyMaxActiveBlocksPerMultiprocessor(&per_cu, (const void*)fwd, 512, LDS_BYTES) != hipSuccess || per_cu < 1) fprintf(stderr, "kernel_launch: occupancy query says %d\n", per_cu);
        (void)hipGetLastError();
        grid = cus;
    }
    if (grid < 0) return;
    (void)hipMemsetAsync((char*)d_ws + WS_CTL, 0, CTL_BYTES, stream);
    Args a{};
    for (int i = 0; i < 25; ++i) a.in[i] = (const float*)d_in[i];
    a.out = (float*)d_out; a.ws = (unsigned char*)d_ws;
#if N_LAUNCH_MODE == 1
    a.ph_lo = 0; a.ph_hi = NPH;
    hipLaunchKernelGGL(fwd, dim3(grid), dim3(512), LDS_BYTES, stream, a);
#if TS_ENABLE
    hipLaunchKernelGGL(ts_spin, dim3(1, grid), dim3(1), 0, stream, (const unsigned*)((unsigned char*)d_ws + WS_CTL));
#endif
#if PROBE_PHASE >= 0
    a.ph_lo = PROBE_PHASE; a.ph_hi = PROBE_PHASE + 1 + PROBE_SPAN; a.out = (float*)((unsigned char*)d_ws + WS_B); a.pflags = PROBE_FLAGS;
    (void)hipMemsetAsync((char*)d_ws + WS_CTL, 0, CTL_BYTES, stream);
    hipLaunchKernelGGL(fwd, dim3(grid), dim3(512), LDS_BYTES, stream, a);
#endif
#else
    for (int ph = 0; ph < NPH; ++ph) { a.ph_lo = ph; a.ph_hi = ph + 1; hipLaunchKernelGGL(fwd, dim3(grid), dim3(512), LDS_BYTES, stream, a); }
#endif
}
```
